# Optimizing an MI355X kernel written in HIP

```python
import jax, jax.numpy as jnp
from jax import lax
import numpy as np


D_MODEL = 1024
BATCH = 16
SEQ = 2048
DEPTH = 4

GRID_W = 64
HEAD_DIM = 64
N_Q_HEADS = 8
N_KV_HEADS = 2
Q_PER_KV = N_Q_HEADS // N_KV_HEADS
ATTN_WIDTH = N_Q_HEADS * HEAD_DIM
KV_WIDTH = N_KV_HEADS * HEAD_DIM
ROPE_THETA = 10000.0
Q_BLOCK = 128
CONV_WIDTH = D_MODEL // 2
POOL_WINDOWS = (2, 4, 8, 16)
N_POOL_GROUPS = 4
POOL_WIDTH = D_MODEL // 2
POOL_GROUP = POOL_WIDTH // N_POOL_GROUPS
SGU_WIDTH = D_MODEL // 2
N_SGU_GROUPS = 4
SGU_GROUP = SGU_WIDTH // N_SGU_GROUPS
SGU_CHUNK = 128
D_FF = 2816
EPS = 1e-6
EVEN_IN = 3 * CONV_WIDTH + ATTN_WIDTH + 2 * KV_WIDTH
EVEN_SPLITS = (CONV_WIDTH, 2 * CONV_WIDTH, 3 * CONV_WIDTH,
               3 * CONV_WIDTH + ATTN_WIDTH, 3 * CONV_WIDTH + ATTN_WIDTH + KV_WIDTH)
EVEN_MIX = CONV_WIDTH + ATTN_WIDTH
ODD_IN = POOL_WIDTH + 2 * SGU_WIDTH
ODD_SPLITS = (POOL_WIDTH, POOL_WIDTH + SGU_WIDTH)
ODD_MIX = POOL_WIDTH + SGU_WIDTH

kernel_name = 'hybrid_conv_gqa_pool_sgu_macaron_encoder'


def rms_norm(x, g):
    xf = x.astype(jnp.float32)
    y = xf * lax.rsqrt(jnp.mean(xf * xf, axis=-1, keepdims=True) + EPS)
    return (y * g.astype(jnp.float32)).astype(x.dtype)


def swiglu(x, w_in, w_out):
    g, u = jnp.split(x @ w_in, 2, axis=-1)
    return (jax.nn.silu(g) * u) @ w_out


def axial_rope_tables(seq):
    rows = seq // GRID_W
    r_idx, c_idx = jnp.meshgrid(jnp.arange(rows), jnp.arange(GRID_W), indexing='ij')
    r_idx = r_idx.reshape(-1).astype(jnp.float32)
    c_idx = c_idx.reshape(-1).astype(jnp.float32)
    n_freq = HEAD_DIM // 4
    inv = ROPE_THETA ** (-jnp.arange(n_freq, dtype=jnp.float32) / n_freq)
    ang = jnp.concatenate([r_idx[:, None] * inv, c_idx[:, None] * inv], axis=-1)
    return jnp.cos(ang), jnp.sin(ang)


def apply_rope(x, cos, sin):
    b, s, h, d = x.shape
    xf = x.astype(jnp.float32).reshape(b, s, h, d // 2, 2)
    x0, x1 = xf[..., 0], xf[..., 1]
    c = cos[None, :, None, :]
    sn = sin[None, :, None, :]
    out = jnp.stack([x0 * c - x1 * sn, x0 * sn + x1 * c], axis=-1)
    return out.reshape(b, s, h, d).astype(x.dtype)


def blocked_gqa(q, k, v):
    b, s, _, _ = q.shape
    nblk = s // Q_BLOCK
    qb = q.reshape(b, nblk, Q_BLOCK, N_KV_HEADS, Q_PER_KV, HEAD_DIM).transpose(1, 0, 2, 3, 4, 5)
    scale = HEAD_DIM ** -0.5

    def one_block(qi):
        sc = jnp.einsum('bqkgd,bskd->bkgqs', qi, k).astype(jnp.float32) * scale
        p = jax.nn.softmax(sc, axis=-1).astype(v.dtype)
        return jnp.einsum('bkgqs,bskd->bqkgd', p, v)

    o = lax.map(one_block, qb)
    return o.transpose(1, 0, 2, 3, 4, 5).reshape(b, s, ATTN_WIDTH)


def short_conv(h, w):
    hp = jnp.pad(h, ((0, 0), (1, 1), (0, 0)))
    return hp[:, :-2] * w[0] + hp[:, 1:-1] * w[1] + hp[:, 2:] * w[2]


def even_mixer(h, w_in, conv_w, q_g, k_g, w_out, cos, sin):
    b, s, _ = h.shape
    gate_b, gate_c, hc, q, k, v = jnp.split(h @ w_in, list(EVEN_SPLITS), axis=-1)
    a_out = gate_b * short_conv(gate_c * hc, conv_w)
    q = apply_rope(rms_norm(q.reshape(b, s, N_Q_HEADS, HEAD_DIM), q_g), cos, sin)
    k = apply_rope(rms_norm(k.reshape(b, s, N_KV_HEADS, HEAD_DIM), k_g), cos, sin)
    v = v.reshape(b, s, N_KV_HEADS, HEAD_DIM)
    b_out = blocked_gqa(q, k, v)
    return jnp.concatenate([a_out, b_out], axis=-1) @ w_out


def multiscale_pool(p):
    b, s, _ = p.shape
    pf = p.astype(jnp.float32)
    cs = jnp.concatenate([jnp.zeros((b, 1, POOL_WIDTH), jnp.float32), jnp.cumsum(pf, axis=1)], axis=1)
    t = jnp.arange(s)
    outs = []
    for gi, w in enumerate(POOL_WINDOWS):
        r = w // 2
        lo = jnp.maximum(t - r, 0)
        hi = jnp.minimum(t + r, s - 1)
        sl = slice(gi * POOL_GROUP, (gi + 1) * POOL_GROUP)
        csg = cs[:, :, sl]
        win = csg[:, hi + 1] - csg[:, lo]
        cnt = (hi - lo + 1).astype(jnp.float32)[None, :, None]
        outs.append(win / cnt - pf[:, :, sl])
    return jnp.concatenate(outs, axis=-1).astype(p.dtype)


def chunked_sgu(u, v, norm_g, w_s, b_s):
    b, s, _ = u.shape
    v = rms_norm(v, norm_g)
    n = s // SGU_CHUNK
    vc = v.reshape(b, n, SGU_CHUNK, N_SGU_GROUPS, SGU_GROUP)
    mixed = jnp.einsum('gpq,bnqgc->bnpgc', w_s, vc) + b_s.T[None, None, :, :, None]
    return u * mixed.reshape(b, s, SGU_WIDTH)


def odd_mixer(h, w_in, pool_w, pool_scale, sgu_norm, sgu_w, sgu_b, w_out):
    b, s, _ = h.shape
    p, u, v = jnp.split(h @ w_in, list(ODD_SPLITS), axis=-1)
    pooled = multiscale_pool(p).reshape(b, s, N_POOL_GROUPS, POOL_GROUP)
    c_out = jnp.einsum('bsgc,gcd->bsgd', pooled, pool_w).reshape(b, s, POOL_WIDTH) * pool_scale
    d_out = chunked_sgu(jax.nn.gelu(u), jax.nn.gelu(v), sgu_norm, sgu_w, sgu_b)
    return jnp.concatenate([c_out, d_out], axis=-1) @ w_out


def setup_inputs(seed: int = 0) -> dict:
    key = jax.random.key(seed)
    ks = jax.random.split(key, 24)
    n_even = (DEPTH + 1) // 2
    n_odd = DEPTH // 2
    f32 = jnp.float32

    def nrm(k, shape, scale):
        return jax.random.normal(k, shape, f32) * scale

    def gain(k, shape):
        return 1.0 + 0.02 * jax.random.normal(k, shape, f32)

    return {
        'x': jax.random.normal(ks[0], (BATCH, SEQ, D_MODEL), f32),
        'ffn1_norm': gain(ks[1], (DEPTH, D_MODEL)),
        'ffn1_w_in': nrm(ks[2], (DEPTH, D_MODEL, 2 * D_FF), D_MODEL ** -0.5),
        'ffn1_w_out': nrm(ks[3], (DEPTH, D_FF, D_MODEL), D_FF ** -0.5),
        'mix_norm': gain(ks[4], (DEPTH, D_MODEL)),
        'ffn2_norm': gain(ks[5], (DEPTH, D_MODEL)),
        'ffn2_w_in': nrm(ks[6], (DEPTH, D_MODEL, 2 * D_FF), D_MODEL ** -0.5),
        'ffn2_w_out': nrm(ks[7], (DEPTH, D_FF, D_MODEL), D_FF ** -0.5),
        'ev_w_in': nrm(ks[8], (n_even, D_MODEL, EVEN_IN), D_MODEL ** -0.5),
        'ev_conv_w': nrm(ks[9], (n_even, 3, CONV_WIDTH), 3 ** -0.5),
        'ev_q_norm': gain(ks[10], (n_even, HEAD_DIM)),
        'ev_k_norm': gain(ks[11], (n_even, HEAD_DIM)),
        'ev_w_out': nrm(ks[12], (n_even, EVEN_MIX, D_MODEL), EVEN_MIX ** -0.5),
        'od_w_in': nrm(ks[13], (n_odd, D_MODEL, ODD_IN), D_MODEL ** -0.5),
        'od_pool_w': nrm(ks[14], (n_odd, N_POOL_GROUPS, POOL_GROUP, POOL_GROUP), POOL_GROUP ** -0.5),
        'od_pool_scale': 1.0 + 0.1 * jax.random.normal(ks[15], (n_odd, POOL_WIDTH), f32),
        'od_sgu_norm': gain(ks[16], (n_odd, SGU_WIDTH)),
        'od_sgu_w': nrm(ks[17], (n_odd, N_SGU_GROUPS, SGU_CHUNK, SGU_CHUNK), SGU_CHUNK ** -0.5),
        'od_sgu_b': 1.0 + 0.01 * jax.random.normal(ks[18], (n_odd, N_SGU_GROUPS, SGU_CHUNK), f32),
        'od_w_out': nrm(ks[19], (n_odd, ODD_MIX, D_MODEL), ODD_MIX ** -0.5),
        'final_norm': gain(ks[20], (D_MODEL,)),
    }


def reference(x, ffn1_norm, ffn1_w_in, ffn1_w_out, mix_norm, ffn2_norm, ffn2_w_in, ffn2_w_out,
              ev_w_in, ev_conv_w, ev_q_norm, ev_k_norm, ev_w_out,
              od_w_in, od_pool_w, od_pool_scale, od_sgu_norm, od_sgu_w, od_sgu_b, od_w_out,
              final_norm):
    s = x.shape[1]
    cos, sin = axial_rope_tables(s)
    for layer in range(DEPTH):
        x = x + 0.5 * swiglu(rms_norm(x, ffn1_norm[layer]), ffn1_w_in[layer], ffn1_w_out[layer])
        h = rms_norm(x, mix_norm[layer])
        j = layer // 2
        if layer % 2 == 0:
            x = x + even_mixer(h, ev_w_in[j], ev_conv_w[j], ev_q_norm[j], ev_k_norm[j], ev_w_out[j], cos, sin)
        else:
            x = x + odd_mixer(h, od_w_in[j], od_pool_w[j], od_pool_scale[j], od_sgu_norm[j],
                              od_sgu_w[j], od_sgu_b[j], od_w_out[j])
        x = x + 0.5 * swiglu(rms_norm(x, ffn2_norm[layer]), ffn2_w_in[layer], ffn2_w_out[layer])
    return rms_norm(x, final_norm)
```

```cpp
#include <hip/hip_runtime.h>
#include <hip/hip_cooperative_groups.h>
#include <hip/hip_bf16.h>
#include <cstdio>
#include <cstdint>
#include <cmath>
namespace pg8 {
#define PG8_LAS __attribute__((address_space(3)))
typedef unsigned short bf16_t;
typedef short bf16x8 __attribute__((ext_vector_type(8)));
typedef float f32x4 __attribute__((ext_vector_type(4)));
typedef unsigned u32x4 __attribute__((ext_vector_type(4)));
constexpr int BM = 256, BK = 64, HALF = 128, HTB = HALF * BK * 2  , STAGE_BYTES = 8 * HTB, NXCD = 8, WGM = 8;

__host__ __device__ __forceinline__ int lds_byte(int r, int c) { const int st = (r >> 4) * 2 + (c >> 5), rr = r & 15, cc = c & 31, ob = rr * 64 + cc * 2; return st * 1024 + (ob ^ (((ob >> 9) & 1) << 5)); }
__host__ __device__ __forceinline__ void stage_rc(int b, int& R, int& C) { const int st = b / 1024, sb = b % 1024, swz = sb ^ (((sb >> 9) & 1) << 5); R = (st >> 1) * 16 + swz / 64; C = (st & 1) * 32 + (swz % 64) / 2; }
__host__ __device__ __forceinline__ int perm32(int rho) { const int n = rho >> 4, i = rho & 15; return 8 * (i >> 2) + 4 * n + (i & 3); }

struct Unit { int pm, pn; };
struct Gemm { const bf16_t* A; const bf16_t* Bt; int M, N, K; };

struct StaticOrder {
    int nM, nN, nwg, G, c;
    __host__ __device__ void init(int M, int N, int G_, int c_) { nM = M / BM; nN = N / BM; nwg = nM * nN; G = G_; c = c_; }
    __host__ __device__ bool next(int i, Unit& u) const {
        const long L = (long)i * G + c; if (L >= nwg) return false;
        int wgid = (int)L; { const int q = nwg / NXCD, r = nwg % NXCD, xcd = wgid % NXCD, off = wgid / NXCD; wgid = (xcd < r ? xcd * (q + 1) : r * (q + 1) + (xcd - r) * q) + off; }
        const int nig = WGM * nN, gid = wgid / nig, fm = gid * WGM, gsz = (nM - fm) < WGM ? (nM - fm) : WGM;
        u.pm = fm + ((wgid % nig) % gsz); u.pn = (wgid % nig) / gsz; return true;
    }
    __device__ __forceinline__ void a_ready(const Unit&) const {}
    __device__ __forceinline__ void done(const Unit&) const {}
};
__device__ __forceinline__ unsigned cvt_pk_bf16(float lo, float hi) { unsigned r; asm volatile("v_cvt_pk_bf16_f32 %0, %1, %2" : "=v"(r) : "v"(lo), "v"(hi)); return r; }
typedef float f32x2 __attribute__((ext_vector_type(2)));
__device__ __forceinline__ float row_rs(const float* ssq, int row) { const f32x4 p = *(const f32x4*)(ssq + 4 * (size_t)row); return __builtin_amdgcn_rsqf(((p[0] + p[1]) + (p[2] + p[3])) * (1.0f / 1024.0f) + 1e-6f); }
__device__ __forceinline__ float silu_f(float g) { return g * __builtin_amdgcn_rcpf(1.0f + __builtin_amdgcn_exp2f(-1.4426950408889634f * g)); }
struct EpiSwiGLU {
    static constexpr bool PERM = true, AFTER_DRAIN = false;
    bf16_t* O; int ldc; const float* ssq;
    __device__ __forceinline__ void operator()(const f32x4 (&acc)[2][2][4][2], const Unit& u, int wr, int wc, int fr, int fq) const {
        const int row0 = u.pm * BM + wr * 64 + fr, col0 = u.pn * HALF + wc * 32 + 8 * fq;
#pragma unroll
        for (int ai = 0; ai < 2; ++ai)
#pragma unroll
            for (int m = 0; m < 4; ++m) { const int row = row0 + ai * HALF + m * 16; const float rs = row_rs(ssq, row);
                const f32x4 g0 = acc[ai][0][m][0] * rs, g1 = acc[ai][0][m][1] * rs, u0 = acc[ai][1][m][0] * rs, u1 = acc[ai][1][m][1] * rs;
                u32x4 w; w.x = cvt_pk_bf16(silu_f(g0[0]) * u0[0], silu_f(g0[1]) * u0[1]); w.y = cvt_pk_bf16(silu_f(g0[2]) * u0[2], silu_f(g0[3]) * u0[3]);
                w.z = cvt_pk_bf16(silu_f(g1[0]) * u1[0], silu_f(g1[1]) * u1[1]); w.w = cvt_pk_bf16(silu_f(g1[2]) * u1[2], silu_f(g1[3]) * u1[3]);
                *(u32x4*)(O + (size_t)row * ldc + col0) = w; }
    }
};
struct EpiRowScale {
    static constexpr bool PERM = true, AFTER_DRAIN = false;
    bf16_t* O; int ldc; const float* ssq;
    __device__ __forceinline__ void operator()(const f32x4 (&acc)[2][2][4][2], const Unit& u, int wr, int wc, int fr, int fq) const {
        const int row0 = u.pm * BM + wr * 64 + fr, col0 = u.pn * BM + wc * 32 + 8 * fq;
#pragma unroll
        for (int ai = 0; ai < 2; ++ai)
#pragma unroll
            for (int m = 0; m < 4; ++m) { const int row = row0 + ai * HALF + m * 16; const float rs = row_rs(ssq, row); bf16_t* rowp = O + (size_t)row * ldc + col0;
#pragma unroll
                for (int bj = 0; bj < 2; ++bj) { const f32x4 v0 = acc[ai][bj][m][0] * rs, v1 = acc[ai][bj][m][1] * rs;
                    u32x4 w; w.x = cvt_pk_bf16(v0[0], v0[1]); w.y = cvt_pk_bf16(v0[2], v0[3]); w.z = cvt_pk_bf16(v1[0], v1[1]); w.w = cvt_pk_bf16(v1[2], v1[3]);
                    *(u32x4*)(rowp + bj * HALF) = w; } }
    }
};
struct EpiResid {
    static constexpr bool PERM = false, AFTER_DRAIN = false;
    const float* base; float* out; bf16_t* xb; float* ssq_out; float alpha;
    __device__ __forceinline__ void operator()(const f32x4 (&acc)[2][2][4][2], const Unit& u, int wr, int wc, int fr, int fq) const {
        typedef unsigned u32x2v __attribute__((ext_vector_type(2)));
        PG8_LAS float* P = (PG8_LAS float*)(STAGE_BYTES);
        const int row0 = u.pm * BM + wr * 64 + fr, col0 = u.pn * BM + wc * 32 + 4 * fq;
#pragma unroll
        for (int ai = 0; ai < 2; ++ai)
#pragma unroll
            for (int m = 0; m < 4; ++m) { const int row = row0 + ai * HALF + m * 16; const size_t off = (size_t)row * 1024 + col0; float s = 0.f;
#pragma unroll
                for (int bj = 0; bj < 2; ++bj)
#pragma unroll
                    for (int n = 0; n < 2; ++n) { const size_t o2 = off + bj * HALF + n * 16; const f32x4 b = *(const f32x4*)(base + o2); const f32x4 o = b + acc[ai][bj][m][n] * alpha;
                        *(f32x4*)(out + o2) = o; s += (o[0] * o[0] + o[1] * o[1]) + (o[2] * o[2] + o[3] * o[3]);
                        u32x2v w; w.x = cvt_pk_bf16(o[0], o[1]); w.y = cvt_pk_bf16(o[2], o[3]); *(u32x2v*)(xb + o2) = w; }
                s += __shfl_xor(s, 16); s += __shfl_xor(s, 32);
                if (fq == 0) P[(ai * HALF + wr * 64 + m * 16 + fr) * 4 + wc] = s;
                if (m & 1) asm volatile("" ::: "memory"); }
        asm volatile("s_waitcnt lgkmcnt(0)" ::: "memory"); __builtin_amdgcn_s_barrier(); asm volatile("" ::: "memory");
        int t = threadIdx.x; asm volatile("" : "+v"(t));
        if (t < 256) { const f32x4 p = *(const PG8_LAS f32x4*)(P + 4 * t); ssq_out[(size_t)(u.pm * BM + t) * 4 + u.pn] = (p[0] + p[1]) + (p[2] + p[3]); }
    }
};

template <class Epi, class Sched, bool ALIGN_EPI = false, bool SP2 = false>
__device__ __forceinline__ void gemm_phase(PG8_LAS unsigned char* lds, const Gemm g, const Sched& S, const Epi& E) {
    int tid_ = threadIdx.x; asm volatile("" : "+v"(tid_));
    const int tid = tid_, wid = __builtin_amdgcn_readfirstlane(tid >> 6), lane = tid & 63, wr = wid >> 2, wc = wid & 3, fr = lane & 15, fq = lane >> 4;
    const int K = g.K, nt = K / BK;
    unsigned voffA[2], voffB[2];
#pragma unroll
    for (int i = 0; i < 2; ++i) { int R, C; stage_rc(tid * 16 + i * 8192, R, C); const int Rb = Epi::PERM ? ((R & ~31) + perm32(R & 31)) : R;
        voffA[i] = (unsigned)(R * K + C) * 2u; voffB[i] = (unsigned)(Rb * K + C) * 2u; }
    const size_t kstep = (size_t)(BK * 2);
    const size_t hstep = (size_t)HALF * K * 2;
    const size_t tstep = 2 * hstep;
    const unsigned ldsw = (unsigned)wid * 1024u;
    const int aoff = lds_byte(wr * 64 + fr, fq * 8), boff = lds_byte(wc * 32 + fr, fq * 8);
#define PG8_SA(b, h) (((b) * 2 + (h)) * HTB)
#define PG8_SB(b, h) ((4 + (b) * 2 + (h)) * HTB)
#define PG8_STAGE(bufoff, gbase, voff) do { _Pragma("unroll") for (int _i = 0; _i < 2; ++_i) \
        __builtin_amdgcn_global_load_lds((const unsigned*)((const char*)(gbase) + (voff)[_i]), (PG8_LAS unsigned*)(lds + (bufoff) + ldsw + _i * 8192), 16, 0, 0); } while (0)
#define PG8_LDA(dst, b, h) do { _Pragma("unroll") for (int m = 0; m < 4; ++m) _Pragma("unroll") for (int k = 0; k < 2; ++k) dst[m][k] = *(const PG8_LAS bf16x8*)(lds + PG8_SA(b, h) + aoff + m * 2048 + k * 1024); } while (0)
#define PG8_LDB(dst, b, h) do { _Pragma("unroll") for (int n = 0; n < 2; ++n) _Pragma("unroll") for (int k = 0; k < 2; ++k) dst[n][k] = *(const PG8_LAS bf16x8*)(lds + PG8_SB(b, h) + boff + n * 2048 + k * 1024); } while (0)
#define PG8_MMA(ai, bj, At, Bt) do { __builtin_amdgcn_s_setprio(1); _Pragma("unroll") for (int m = 0; m < 4; ++m) _Pragma("unroll") for (int n = 0; n < 2; ++n) _Pragma("unroll") for (int k = 0; k < 2; ++k) \
        acc[ai][bj][m][n] = __builtin_amdgcn_mfma_f32_16x16x32_bf16(Bt[n][k], At[m][k], acc[ai][bj][m][n], 0, 0, 0); __builtin_amdgcn_s_setprio(0); } while (0)
#define PG8_WAIT_V(n) asm volatile("s_waitcnt vmcnt(" #n ")" ::: "memory")
#define PG8_WAIT_L(n) asm volatile("s_waitcnt lgkmcnt(" #n ")" ::: "memory")
#define PG8_BAR __builtin_amdgcn_s_barrier()
#define PG8_SCHED __builtin_amdgcn_sched_barrier(0)
    Unit cur, nxt; int ui = 0;
    if (!S.next(0, cur)) return;
    f32x4 acc[2][2][4][2];
#pragma unroll
    for (int a = 0; a < 2; ++a)
#pragma unroll
        for (int b = 0; b < 2; ++b)
#pragma unroll
            for (int m = 0; m < 4; ++m)
#pragma unroll
                for (int n = 0; n < 2; ++n) acc[a][b][m][n] = (f32x4){0.f, 0.f, 0.f, 0.f};
    bf16x8 At[4][2], B0[2][2], B1[2][2];
    const char* cA = (const char*)g.A + (size_t)cur.pm * tstep; const char* cB = (const char*)g.Bt + (size_t)cur.pn * tstep;
    S.a_ready(cur);
    if constexpr (SP2) {
        PG8_STAGE(PG8_SB(0, 0), cB, voffB); PG8_STAGE(PG8_SB(0, 1), cB + hstep, voffB); PG8_STAGE(PG8_SA(0, 0), cA, voffA); PG8_STAGE(PG8_SA(0, 1), cA + hstep, voffA);
        if (wr == 1) PG8_BAR;
        PG8_WAIT_V(2); PG8_BAR;
        PG8_STAGE(PG8_SB(1, 0), cB + kstep, voffB); PG8_STAGE(PG8_SA(1, 0), cA + kstep, voffA); PG8_STAGE(PG8_SB(1, 1), cB + hstep + kstep, voffB);
        PG8_WAIT_V(6); PG8_BAR;
    } else {
        PG8_STAGE(PG8_SB(0, 0), cB, voffB); PG8_STAGE(PG8_SA(0, 0), cA, voffA); PG8_STAGE(PG8_SB(0, 1), cB + hstep, voffB); PG8_STAGE(PG8_SA(0, 1), cA + hstep, voffA);
        if (wr == 1) PG8_BAR;
        PG8_WAIT_V(4); PG8_BAR;
        PG8_STAGE(PG8_SB(1, 0), cB + kstep, voffB); PG8_STAGE(PG8_SA(1, 0), cA + kstep, voffA); PG8_STAGE(PG8_SB(1, 1), cB + hstep + kstep, voffB);
        PG8_WAIT_V(6); PG8_BAR;
    }
    for (;;) {
        const bool has_next = S.next(ui + 1, nxt);
        const char* nA = has_next ? (const char*)g.A + (size_t)nxt.pm * tstep : cA; const char* nB = has_next ? (const char*)g.Bt + (size_t)nxt.pn * tstep : cB;
        for (int t = 0; t < nt; t += 2) {
            const bool last = (t == nt - 2);
            const char* a1 = cA + (size_t)(t + 1) * kstep;
            const char* a2 = last ? nA : cA + (size_t)(t + 2) * kstep; const char* b2 = last ? nB : cB + (size_t)(t + 2) * kstep;
            const char* a3 = a2 + kstep; const char* b3 = b2 + kstep;
            if (last && has_next) S.a_ready(nxt);
            if constexpr (SP2) {
            PG8_LDB(B0, 0, 0); PG8_LDB(B1, 0, 1); PG8_SCHED; PG8_LDA(At, 0, 0); PG8_STAGE(PG8_SA(1, 1), a1 + hstep, voffA);
            PG8_WAIT_V(8); PG8_WAIT_L(0); PG8_BAR; PG8_MMA(0, 0, At, B0); PG8_MMA(0, 1, At, B1); PG8_BAR; PG8_SCHED;
            PG8_LDA(At, 0, 1); PG8_STAGE(PG8_SB(0, 0), b2, voffB); PG8_STAGE(PG8_SB(0, 1), b2 + hstep, voffB); PG8_STAGE(PG8_SA(0, 0), a2, voffA);
            PG8_WAIT_V(8); PG8_WAIT_L(0); PG8_BAR; PG8_MMA(1, 0, At, B0); PG8_MMA(1, 1, At, B1); PG8_BAR; PG8_SCHED;
            PG8_LDB(B0, 1, 0); PG8_LDB(B1, 1, 1); PG8_SCHED; PG8_LDA(At, 1, 0); PG8_STAGE(PG8_SA(0, 1), a2 + hstep, voffA);
            PG8_WAIT_V(8); PG8_WAIT_L(0); PG8_BAR; PG8_MMA(0, 0, At, B0); PG8_MMA(0, 1, At, B1); PG8_BAR; PG8_SCHED;
            PG8_LDA(At, 1, 1); PG8_STAGE(PG8_SB(1, 0), b3, voffB); PG8_STAGE(PG8_SB(1, 1), b3 + hstep, voffB); PG8_STAGE(PG8_SA(1, 0), a3, voffA);
            PG8_WAIT_V(8); PG8_WAIT_L(0); PG8_BAR; PG8_MMA(1, 0, At, B0); PG8_MMA(1, 1, At, B1); PG8_BAR; PG8_SCHED;
            } else {
            PG8_LDB(B0, 0, 0); PG8_SCHED; PG8_LDA(At, 0, 0); PG8_STAGE(PG8_SA(1, 1), a1 + hstep, voffA);
            PG8_WAIT_L(8); PG8_BAR; PG8_WAIT_L(0); PG8_MMA(0, 0, At, B0); PG8_BAR; PG8_SCHED;
            PG8_LDB(B1, 0, 1); PG8_STAGE(PG8_SB(0, 0), b2, voffB);
            PG8_BAR; PG8_WAIT_L(0); PG8_MMA(0, 1, At, B1); PG8_BAR;
            PG8_LDA(At, 0, 1); PG8_STAGE(PG8_SA(0, 0), a2, voffA);
            PG8_BAR; PG8_WAIT_L(0); PG8_MMA(1, 0, At, B0); PG8_BAR; PG8_SCHED;
            PG8_STAGE(PG8_SB(0, 1), b2 + hstep, voffB);
            PG8_WAIT_V(6); PG8_BAR; PG8_MMA(1, 1, At, B1); PG8_BAR;
            PG8_LDB(B0, 1, 0); PG8_SCHED; PG8_LDA(At, 1, 0); PG8_STAGE(PG8_SA(0, 1), a2 + hstep, voffA);
            PG8_WAIT_L(8); PG8_BAR; PG8_WAIT_L(0); PG8_MMA(0, 0, At, B0); PG8_BAR; PG8_SCHED;
            PG8_LDB(B1, 1, 1); PG8_STAGE(PG8_SB(1, 0), b3, voffB);
            PG8_BAR; PG8_WAIT_L(0); PG8_MMA(0, 1, At, B1); PG8_BAR;
            PG8_LDA(At, 1, 1); PG8_STAGE(PG8_SA(1, 0), a3, voffA);
            PG8_BAR; PG8_WAIT_L(0); PG8_MMA(1, 0, At, B0); PG8_BAR; PG8_SCHED;
            PG8_STAGE(PG8_SB(1, 1), b3 + hstep, voffB);
            PG8_WAIT_V(6); PG8_BAR; PG8_MMA(1, 1, At, B1); PG8_BAR;
            }
        }
        if constexpr (ALIGN_EPI) { if (wr == 0) PG8_BAR; }
        if constexpr (!Epi::AFTER_DRAIN) { E(acc, cur, wr, wc, fr, fq); S.done(cur); }
        if (!has_next) break;
#pragma unroll
        for (int a = 0; a < 2; ++a)
#pragma unroll
            for (int b = 0; b < 2; ++b)
#pragma unroll
                for (int m = 0; m < 4; ++m)
#pragma unroll
                    for (int n = 0; n < 2; ++n) acc[a][b][m][n] = (f32x4){0.f, 0.f, 0.f, 0.f};
        cur = nxt; cA = nA; cB = nB; ++ui;
        if constexpr (ALIGN_EPI) { if (wr == 1) PG8_BAR; }
    }
    PG8_WAIT_V(0);
    if constexpr (!ALIGN_EPI) { if (wr == 0) PG8_BAR; }
    PG8_BAR;
    if constexpr (Epi::AFTER_DRAIN) { E.fused(acc, cur, wr, wc, fr, fq, lds, wid, lane); S.done(cur); }
#undef PG8_SA
#undef PG8_SB
#undef PG8_STAGE
#undef PG8_LDA
#undef PG8_LDB
#undef PG8_MMA
#undef PG8_WAIT_V
#undef PG8_WAIT_L
#undef PG8_BAR
#undef PG8_SCHED
}
}
namespace attn_body {
using bf16=__hip_bfloat16;
using bf16x8=__attribute__((ext_vector_type(8)))short;
using s16x4=__attribute__((ext_vector_type(4)))short;
using f32x16=__attribute__((ext_vector_type(16)))float;
using u32x4=__attribute__((ext_vector_type(4)))unsigned;
constexpr int BATCH=16,NHEAD=8,SEQ=2048,D=64,PQ=2304,PO=1024;
constexpr int NW=8,QBLK=32,QB=QBLK*NW,KVBLK=64,NQB=SEQ/QB;
constexpr int ATTN_UNIT_ROWS=QB;
__device__ __forceinline__ int crow(int r,int hi){return (r&3)+8*(r>>2)+4*hi;}
#define SBAR() __builtin_amdgcn_sched_barrier(0)
__device__ __forceinline__ void cmask(f32x16&p0,f32x16&p1,int jb,int qrel,int hi){
  const float NEG=-INFINITY; int kb=64*jb+4*hi;
  #pragma unroll
  for(int r=0;r<16;++r){int kv=kb+(r&3)+8*(r>>2); if(kv>qrel)p0[r]=NEG; if(kv+32>qrel)p1[r]=NEG;}
}

constexpr int NSLOT=3, SLOTB=8192;
constexpr int LDS_K=0, LDS_V=NSLOT*SLOTB, LDS_WS=2*NSLOT*SLOTB, LDS_OST=LDS_WS+NW*64*4, LDS_BYTES=LDS_OST+NW*4096;
constexpr float C2=0.125f*1.4426950408889634f;
__device__ __forceinline__ void glds16(const void*gsrc,unsigned lds_dst){unsigned keep;
  asm volatile("s_mov_b32 %0, m0\n\ts_mov_b32 m0, %2\n\ts_nop 0\n\tglobal_load_lds_dwordx4 %1, off\n\ts_mov_b32 m0, %0":"=&s"(keep):"v"(gsrc),"s"(lds_dst):"memory");}
__device__ __forceinline__ float max3f(float a,float b,float c){float r;asm("v_max3_f32 %0, %1, %2, %3":"=v"(r):"v"(a),"v"(b),"v"(c));return r;}
__device__ __forceinline__ float max2f(float a,float b){float r;asm("v_max_f32_e32 %0, %1, %2":"=v"(r):"v"(a),"v"(b));return r;}
__device__ __forceinline__ float fadd_s(float a,float b){float r;asm("v_add_f32_e32 %0, %1, %2":"=v"(r):"v"(a),"v"(b));return r;}
__device__ __forceinline__ float fsub_s(float a,float b){float r;asm("v_sub_f32_e32 %0, %1, %2":"=v"(r):"v"(a),"v"(b));return r;}
typedef float f32x2_t __attribute__((ext_vector_type(2))); typedef __bf16 bf16x2_t __attribute__((ext_vector_type(2)));
__device__ __forceinline__ unsigned cvtpk_s(float lo,float hi){f32x2_t v={lo,hi};bf16x2_t b=__builtin_convertvector(v,bf16x2_t);return __builtin_bit_cast(unsigned,b);}
#define WAIT_BAR(N) asm volatile("s_waitcnt vmcnt(" #N ") lgkmcnt(0)\n\ts_barrier":::"memory")

__device__ __forceinline__ void qkt(f32x16&p0,f32x16&p1,const char*Kslot,const bf16x8*qr,const f32x16&negm,int r32,int hi){
  const char*kb=Kslot+hi*1024+r32*16;
  #pragma unroll
  for(int d0=0;d0<4;++d0){
    const bf16x8 b0=*reinterpret_cast<const bf16x8*>(kb+d0*2048);
    const bf16x8 b1=*reinterpret_cast<const bf16x8*>(kb+d0*2048+512);
    if(d0==0){p0=__builtin_amdgcn_mfma_f32_32x32x16_bf16(b0,qr[0],negm,0,0,0);p1=__builtin_amdgcn_mfma_f32_32x32x16_bf16(b1,qr[0],negm,0,0,0);}
    else{p0=__builtin_amdgcn_mfma_f32_32x32x16_bf16(b0,qr[d0],p0,0,0,0);p1=__builtin_amdgcn_mfma_f32_32x32x16_bf16(b1,qr[d0],p1,0,0,0);}}
}
typedef __attribute__((address_space(3))) const char* lds_cptr;
typedef short v4i16_t __attribute__((ext_vector_type(4)));
__device__ __forceinline__ void kload8(bf16x8*kf,lds_cptr kp){
  kf[0]=*(const __attribute__((address_space(3))) bf16x8*)(kp);      kf[1]=*(const __attribute__((address_space(3))) bf16x8*)(kp+512);
  kf[2]=*(const __attribute__((address_space(3))) bf16x8*)(kp+2048); kf[3]=*(const __attribute__((address_space(3))) bf16x8*)(kp+2560);
  kf[4]=*(const __attribute__((address_space(3))) bf16x8*)(kp+4096); kf[5]=*(const __attribute__((address_space(3))) bf16x8*)(kp+4608);
  kf[6]=*(const __attribute__((address_space(3))) bf16x8*)(kp+6144); kf[7]=*(const __attribute__((address_space(3))) bf16x8*)(kp+6656);
}
__device__ __forceinline__ void kload2(bf16x8*kf,lds_cptr kp,int j){ kf[2*j]=*(const __attribute__((address_space(3))) bf16x8*)(kp+j*2048); kf[2*j+1]=*(const __attribute__((address_space(3))) bf16x8*)(kp+j*2048+512); }
__device__ __forceinline__ s16x4 vtr(lds_cptr p){ return __builtin_bit_cast(s16x4,__builtin_amdgcn_ds_read_tr16_b64_v4i16((__attribute__((address_space(3))) v4i16_t*)p)); }
__device__ __forceinline__ float rowmax(const f32x16&p0,const f32x16&p1){
  float a=max3f(p0[0],p0[1],p1[0]),b=max3f(p0[2],p0[3],p1[1]);a=max3f(a,p1[2],p1[3]);
  #pragma unroll
  for(int r=4;r<16;r+=4){a=max3f(a,p0[r],p0[r+1]);b=max3f(b,p0[r+2],p0[r+3]);a=max3f(a,p1[r],p1[r+1]);b=max3f(b,p1[r+2],p1[r+3]);}
  const float m=max2f(a,b);
  auto rr=__builtin_amdgcn_permlane32_swap(__float_as_uint(m),__float_as_uint(m),false,false);
  return max2f(__uint_as_float(rr[0]),__uint_as_float(rr[1]));
}
__device__ __forceinline__ void pv(f32x16*o,int vb,bf16x8 pa0,bf16x8 pa1,bf16x8 pa2,bf16x8 pa3){
  #pragma unroll
  for(int d0=0;d0<2;++d0){s16x4 lo[4],hi[4];
    #pragma unroll
    for(int ks=0;ks<4;++ks){
      asm volatile("ds_read_b64_tr_b16 %0,%1 offset:%c2":"=&v"(lo[ks]):"v"(vb),"i"(d0*4096+ks*1024):"memory");
      asm volatile("ds_read_b64_tr_b16 %0,%1 offset:%c2":"=&v"(hi[ks]):"v"(vb),"i"(d0*4096+ks*1024+512):"memory");}
    asm volatile("s_waitcnt lgkmcnt(0)":::"memory");SBAR();
    #define PK(k) (bf16x8){lo[k][0],lo[k][1],lo[k][2],lo[k][3],hi[k][0],hi[k][1],hi[k][2],hi[k][3]}
    o[d0]=__builtin_amdgcn_mfma_f32_32x32x16_bf16(pa0,PK(0),o[d0],0,0,0);
    o[d0]=__builtin_amdgcn_mfma_f32_32x32x16_bf16(pa1,PK(1),o[d0],0,0,0);
    o[d0]=__builtin_amdgcn_mfma_f32_32x32x16_bf16(pa2,PK(2),o[d0],0,0,0);
    o[d0]=__builtin_amdgcn_mfma_f32_32x32x16_bf16(pa3,PK(3),o[d0],0,0,0);
    #undef PK
  }
}

#ifndef ATTN_STORE16
#define ATTN_STORE16(p,v) (*(u32x4*)(p)=(v))
#endif
template<int THRL> __device__ __forceinline__ void attn_unit(int b,int qb,const bf16*Q,const bf16*__restrict__ K,const bf16*__restrict__ V,bf16*O,char*shm){
  int tid_=threadIdx.x; asm volatile("":"+v"(tid_)); const int tid=tid_,lane=tid&63,r32=lane&31,hi=lane>>5; const int wid=__builtin_amdgcn_readfirstlane(tid>>6);
  const long rowbase=(long)b*SEQ; const int q0=qb*QB;
  const bf16*Qw=Q+(rowbase+q0+wid*QBLK)*PQ;
  const bf16*Kh=K+rowbase*PQ,*Vh=V+rowbase*PQ;
  const unsigned lds0=(unsigned)(uintptr_t)shm;
  float*wsf=(float*)(shm+LDS_WS)+wid*64;
  const bf16*ksrc=Kh+(long)lane*PQ+wid*8;
  const bf16*vsrc=Vh+(long)(16*(wid&3)+(lane>>2))*PQ+(wid>>2)*32+(lane&3)*8;
  const unsigned kdst=lds0+LDS_K+wid*1024, vdst=lds0+LDS_V+wid*1024;
  #define DMA_K(t,slot) glds16(ksrc+(long)(t)*KVBLK*PQ,(unsigned)__builtin_amdgcn_readfirstlane(kdst+(slot)))
  #define DMA_V(t,slot) glds16(vsrc+(long)(t)*KVBLK*PQ,(unsigned)__builtin_amdgcn_readfirstlane(vdst+(slot)))
  const int vb0=(int)(lds0+LDS_V)+((lane>>4)&1)*32+(lane&3)*8+(4*hi+((lane&15)>>2))*64;
  const char*Kbase=shm+LDS_K; bf16x8 kf[8];
  const lds_cptr shm3=(lds_cptr)shm; const lds_cptr kp0=shm3+LDS_K+hi*1024+r32*16; const lds_cptr vp0=shm3+LDS_V+((lane>>4)&1)*32+(lane&3)*8+(4*hi+((lane&15)>>2))*64;
  int NT=SEQ/KVBLK; asm volatile("":"+s"(NT));
  DMA_K(0,0);DMA_V(0,0);DMA_K(1,SLOTB);
  bf16x8 qr[4];
  #pragma unroll
  for(int d0=0;d0<4;++d0)qr[d0]=*reinterpret_cast<const bf16x8*>(&Qw[(long)r32*PQ+d0*16+hi*8]);
  float mhat=0.f,l_reg=0.f;f32x16 o[2];o[0]=f32x16{};o[1]=f32x16{};f32x16 negm=f32x16{};asm volatile("":"+v"(negm));
    #define CMASK(P0,P1,t) do{}while(0)
  bool resc=false;
  #define START(P0,P1) do{ const float rm=rowmax(P0,P1); resc=false; \
    { const float dl=rm; mhat=fadd_s(mhat,dl); \
      _Pragma("unroll") for(int r=0;r<16;++r){P0[r]=fsub_s(P0[r],dl);P1[r]=fsub_s(P1[r],dl);} \
      _Pragma("unroll") for(int r=0;r<16;++r)negm[r]=-mhat; asm volatile("":"+v"(negm)); } \
    _Pragma("unroll") for(int r=0;r<16;++r)P0[r]=__builtin_amdgcn_exp2f(P0[r]); }while(0)
  #define RESC() do{ if(resc){ asm volatile("s_waitcnt lgkmcnt(0)":::"memory"); \
      _Pragma("unroll") for(int d_=0;d_<2;++d_) _Pragma("unroll") for(int r=0;r<16;++r)o[d_][r]*=wsf[crow(r,hi)]; } }while(0)
  f32x16 pA0,pA1,pB0,pB1;
  int sl_prev=0,sl_cur=0,sl_next=SLOTB;
  #define ROT() do{sl_prev=sl_cur;sl_cur=sl_next;sl_next=(sl_next==(NSLOT-1)*SLOTB)?0:sl_next+SLOTB;}while(0)
  DMA_K(2,2*SLOTB);
  WAIT_BAR(3);
  qkt(pA0,pA1,Kbase,qr,negm,r32,hi);asm volatile("s_nop 15\n\ts_nop 7":"+v"(pA0),"+v"(pA1));CMASK(pA0,pA1,0);
  START(pA0,pA1);
  _Pragma("unroll") for(int r=0;r<16;++r)pA1[r]=__builtin_amdgcn_exp2f(pA1[r]);
  WAIT_BAR(0);
  DMA_K(3,0);DMA_V(1,SLOTB);
  ROT();
  kload8(kf,kp0+sl_cur);
  WAIT_BAR(2);
  s16x4 vlo[8],vhi[8]; u32x4 pw0,pw1,pw2,pw3;
  #define PKW(P,B) cvtpk_s(P[B],P[B+1])
  #define PAF(k) __builtin_bit_cast(bf16x8,pw##k)
  #define VFR(i) (bf16x8){vlo[i][0],vlo[i][1],vlo[i][2],vlo[i][3],vhi[i][0],vhi[i][1],vhi[i][2],vhi[i][3]}
  #define PIN(x) asm volatile("":"+v"(x))
  #define MX3(a,b,c) __builtin_fmaxf(__builtin_fmaxf((a),(b)),(c))
  #define GAPA(MF,A0,A1,A2,A3,W0,W1,PW) do{ MF; sacc+=A0; sacc+=A1; sacc+=A2; sacc+=A3; PIN(sacc); W0; W1; PIN(PW); SBAR(); }while(0)
  #define EX(v) __builtin_amdgcn_exp2f(v)
  #define GAPB(MF,X,B) do{ MF; X[B]=EX(X[B]); X[B+1]=EX(X[B+1]); X[B+2]=EX(X[B+2]); X[B+3]=EX(X[B+3]); PIN(X); SBAR(); }while(0)
  #define VRD(i) do{ vlo[i]=vtr(vp_+(((i)>>2)*4096+((i)&3)*1024)); vhi[i]=vtr(vp_+(((i)>>2)*4096+((i)&3)*1024+512)); }while(0)
  #define KRD(G,j) do{ if(G){ kload2(kf,kp0+sl_next,j); SBAR(); } }while(0)
  #define STEP(C0,C1,P0,P1,t,GK,GV,GL) do{ SBAR(); \
    const lds_cptr vp_=vp0+sl_prev; \
    VRD(0); SBAR(); float sacc=(P0[0]+P0[1]); \
    GAPA(C0=__builtin_amdgcn_mfma_f32_32x32x16_bf16(kf[0],qr[0],negm,0,0,0), P0[2],P0[3],P0[4],P0[5],     pw0[0]=PKW(P0,0), pw0[1]=PKW(P0,2), pw0); \
    VRD(4); SBAR(); GAPA(C1=__builtin_amdgcn_mfma_f32_32x32x16_bf16(kf[1],qr[0],negm,0,0,0), P0[6],P0[7],P0[8],P0[9],     pw0[2]=PKW(P0,4), pw0[3]=PKW(P0,6), pw0); \
    VRD(1); SBAR(); GAPA(C0=__builtin_amdgcn_mfma_f32_32x32x16_bf16(kf[2],qr[1],C0,0,0,0),   P0[10],P0[11],P0[12],P0[13], pw1[0]=PKW(P0,8), pw1[1]=PKW(P0,10), pw1); \
    VRD(5); SBAR(); GAPA(C1=__builtin_amdgcn_mfma_f32_32x32x16_bf16(kf[3],qr[1],C1,0,0,0),   P0[14],P0[15],P1[0],P1[1],   pw1[2]=PKW(P0,12),pw1[3]=PKW(P0,14), pw1); \
    VRD(2); SBAR(); GAPA(C0=__builtin_amdgcn_mfma_f32_32x32x16_bf16(kf[4],qr[2],C0,0,0,0),   P1[2],P1[3],P1[4],P1[5],     pw2[0]=PKW(P1,0), pw2[1]=PKW(P1,2), pw2); \
    VRD(6); SBAR(); GAPA(C1=__builtin_amdgcn_mfma_f32_32x32x16_bf16(kf[5],qr[2],C1,0,0,0),   P1[6],P1[7],P1[8],P1[9],     pw2[2]=PKW(P1,4), pw2[3]=PKW(P1,6), pw2); \
    VRD(3); SBAR(); GAPA(C0=__builtin_amdgcn_mfma_f32_32x32x16_bf16(kf[6],qr[3],C0,0,0,0),   P1[10],P1[11],P1[12],P1[13], pw3[0]=PKW(P1,8), pw3[1]=PKW(P1,10), pw3); \
    VRD(7); SBAR(); GAPA(C1=__builtin_amdgcn_mfma_f32_32x32x16_bf16(kf[7],qr[3],C1,0,0,0),   P1[14],P1[15],0.f,0.f,       pw3[2]=PKW(P1,12),pw3[3]=PKW(P1,14), pw3); \
    l_reg+=sacc; \
    if(GK){DMA_K((t)+3,sl_cur);} if(GV){DMA_V((t)+1,sl_next);} \
    CMASK(C0,C1,t); \
    { float a=MX3(C0[0],C0[1],C1[0]),b=MX3(C0[2],C0[3],C1[1]); a=MX3(a,C1[2],C1[3]); \
      _Pragma("unroll") for(int r=4;r<16;r+=4){a=MX3(a,C0[r],C0[r+1]);b=MX3(b,C0[r+2],C0[r+3]);a=MX3(a,C1[r],C1[r+1]);b=MX3(b,C1[r+2],C1[r+3]);} \
      float rm=__builtin_fmaxf(a,b); { auto rr=__builtin_amdgcn_permlane32_swap(__float_as_uint(rm),__float_as_uint(rm),false,false); rm=__builtin_fmaxf(__uint_as_float(rr[0]),__uint_as_float(rr[1])); } \
      resc=false; \
      if(__builtin_expect(__any(rm>(float)THRL),0)){ const float dl=__builtin_fmaxf(rm,0.f); mhat+=dl; \
        _Pragma("unroll") for(int r=0;r<16;++r){C0[r]-=dl;C1[r]-=dl;} \
        _Pragma("unroll") for(int r=0;r<16;++r)negm[r]=-mhat; asm volatile("":"+v"(negm)); \
        const float f=__builtin_amdgcn_exp2f(-dl); l_reg*=f; if(hi==0)wsf[r32]=f; resc=true; } } \
    SBAR(); \
    GAPB(o[0]=__builtin_amdgcn_mfma_f32_32x32x16_bf16(PAF(0),VFR(0),o[0],0,0,0), C0,0); \
    GAPB(o[1]=__builtin_amdgcn_mfma_f32_32x32x16_bf16(PAF(0),VFR(4),o[1],0,0,0), C0,4); \
    KRD(GL,0); GAPB(o[0]=__builtin_amdgcn_mfma_f32_32x32x16_bf16(PAF(1),VFR(1),o[0],0,0,0), C0,8); \
    KRD(GL,1); GAPB(o[1]=__builtin_amdgcn_mfma_f32_32x32x16_bf16(PAF(1),VFR(5),o[1],0,0,0), C0,12); \
    KRD(GL,2); GAPB(o[0]=__builtin_amdgcn_mfma_f32_32x32x16_bf16(PAF(2),VFR(2),o[0],0,0,0), C1,0); \
    KRD(GL,3); GAPB(o[1]=__builtin_amdgcn_mfma_f32_32x32x16_bf16(PAF(2),VFR(6),o[1],0,0,0), C1,4); \
    GAPB(o[0]=__builtin_amdgcn_mfma_f32_32x32x16_bf16(PAF(3),VFR(3),o[0],0,0,0), C1,8); \
    GAPB(o[1]=__builtin_amdgcn_mfma_f32_32x32x16_bf16(PAF(3),VFR(7),o[1],0,0,0), C1,12); \
    }while(0)
  int t=1;
  #undef CMASK
  #define CMASK(P0,P1,t) do{}while(0)
  for(;t+5<NT;t+=2){
    STEP(pB0,pB1,pA0,pA1,t,true,true,true);     WAIT_BAR(2); RESC(); ROT();
    STEP(pA0,pA1,pB0,pB1,t+1,true,true,true);   WAIT_BAR(2); RESC(); ROT();
  }
  #undef CMASK
  #define CMASK(P0,P1,t) do{}while(0)
  #define ENDW(tt) do{ if((tt)+3<NT){WAIT_BAR(2);} else if((tt)+2<NT){WAIT_BAR(1);} else {WAIT_BAR(0);} }while(0)
  for(;t+1<NT;t+=2){
    STEP(pB0,pB1,pA0,pA1,t,(t+3<NT),(t+1<NT),(t+1<NT));       ENDW(t);   RESC(); ROT();
    STEP(pA0,pA1,pB0,pB1,t+1,(t+4<NT),(t+2<NT),(t+2<NT));     ENDW(t+1); RESC(); ROT();
  }
  STEP(pB0,pB1,pA0,pA1,NT-1,false,false,false); RESC();
  { float sacc=pB0[0]+pB0[1]; _Pragma("unroll") for(int r=2;r<16;++r)sacc+=pB0[r]; _Pragma("unroll") for(int r=0;r<16;++r)sacc+=pB1[r]; l_reg+=sacc;
    pw0=(u32x4){PKW(pB0,0),PKW(pB0,2),PKW(pB0,4),PKW(pB0,6)};pw1=(u32x4){PKW(pB0,8),PKW(pB0,10),PKW(pB0,12),PKW(pB0,14)};pw2=(u32x4){PKW(pB1,0),PKW(pB1,2),PKW(pB1,4),PKW(pB1,6)};pw3=(u32x4){PKW(pB1,8),PKW(pB1,10),PKW(pB1,12),PKW(pB1,14)};
    SBAR(); pv(o,vb0+sl_cur,PAF(0),PAF(1),PAF(2),PAF(3)); }
  #undef PKW
  #undef PAF
  #undef VFR
  #undef PIN
  #undef MX3
  #undef GAPA
  #undef GAPB
  #undef EX
  #undef VRD
  #undef KRD
  #undef STEP
  #undef ENDW
  {auto rr=__builtin_amdgcn_permlane32_swap(__float_as_uint(l_reg),__float_as_uint(l_reg),false,false);l_reg=__uint_as_float(rr[0])+__uint_as_float(rr[1]);}
  if(hi==0)wsf[32+r32]=l_reg;asm volatile("s_waitcnt lgkmcnt(0)":::"memory");
  float rli[16];
  #pragma unroll
  for(int r=0;r<16;++r)rli[r]=__builtin_amdgcn_rcpf(wsf[32+crow(r,hi)]);
  bf16*Ow=O+(rowbase+q0+wid*QBLK)*PO;
  { bf16*stg=(bf16*)(shm+LDS_OST)+wid*2048;
    #pragma unroll
    for(int r=0;r<16;++r){const int orow=crow(r,hi);
      #pragma unroll
      for(int d0=0;d0<2;++d0)stg[orow*64+d0*32+r32]=__float2bfloat16(o[d0][r]*rli[r]);}
    asm volatile("s_waitcnt lgkmcnt(0)":::"memory");
    #pragma unroll
    for(int i=0;i<4;++i){const int row=i*8+(lane>>3),ch=lane&7; const u32x4 v=*(const u32x4*)(stg+row*64+ch*8); ATTN_STORE16(Ow+(long)row*PO+ch*8,v);} }
  asm volatile("s_waitcnt lgkmcnt(0)\n\ts_barrier":::"memory");
  #undef DMA_K
  #undef DMA_V
  #undef CMASK
  #undef START
  #undef RESC
  #undef ROT
}
constexpr int ATTN_LDS_BYTES=LDS_BYTES;
#undef SBAR
#undef WAIT_BAR
}
namespace cg = cooperative_groups;
constexpr int NWAVES = 8;
constexpr int M = 32768, DMODEL = 1024, DFF = 2816, SEQ = 2048, EV_IN = 2304, OD_IN = 1536;
constexpr float EPS = 1e-6f;
constexpr size_t MiB = 1u << 20;
constexpr size_t WS_SSQ = 432 * MiB;
constexpr size_t WS_SGUW = 2 * MiB;
constexpr size_t WS_W1T = 4 * MiB;
constexpr size_t WS_W2T = 92 * MiB;
constexpr size_t WS_EVIN = 136 * MiB;
constexpr size_t WS_EVOUT = 145 * MiB;
constexpr size_t WS_ODIN = 149 * MiB;
constexpr size_t WS_ODOUT = 155 * MiB;
constexpr size_t WS_XB = 160 * MiB;
constexpr size_t WS_ACT = 224 * MiB;
constexpr size_t WS_PROJ = 224 * MiB;
constexpr size_t WS_MIX = 368 * MiB;
constexpr size_t WS_END = 440 * MiB;
constexpr int RING_BYTES = 131072, LDS_BYTES = 147456;

#define GAS __attribute__((address_space(1)))
#define LAS __attribute__((address_space(3)))
typedef unsigned short bf16;
typedef unsigned v4u __attribute__((ext_vector_type(4)));
typedef unsigned v2u __attribute__((ext_vector_type(2)));
typedef float f32x4 __attribute__((ext_vector_type(4)));
typedef short bf16x8 __attribute__((ext_vector_type(8)));
#define LDS_WAIT() asm volatile("s_waitcnt lgkmcnt(0)" ::: "memory")
__device__ __forceinline__ unsigned f2bf(float f) { unsigned u = __builtin_bit_cast(unsigned, f); return (u + 0x7fffu + ((u >> 16) & 1u)) >> 16; }
__device__ __forceinline__ unsigned pk2(float lo, float hi) { return pg8::cvt_pk_bf16(lo, hi); }
__device__ __forceinline__ float bflo(unsigned u) { return __builtin_bit_cast(float, u << 16); }
__device__ __forceinline__ float bfhi(unsigned u) { return __builtin_bit_cast(float, u & 0xffff0000u); }
#define UNPACK8(X_, W_) do { X_[0] = bflo(W_[0]); X_[1] = bfhi(W_[0]); X_[2] = bflo(W_[1]); X_[3] = bfhi(W_[1]); X_[4] = bflo(W_[2]); X_[5] = bfhi(W_[2]); X_[6] = bflo(W_[3]); X_[7] = bfhi(W_[3]); } while (0)
__device__ __forceinline__ float gelu_tanh(float x) {
    const float z2 = 1.5957691216057308f * (x + 0.044715f * x * x * x);
    return x * __builtin_amdgcn_rcpf(1.0f + __builtin_amdgcn_exp2f(-1.4426950408889634f * z2));
}
__device__ __forceinline__ float wave_sum(float v) {
#pragma unroll
    for (int o = 1; o < 64; o <<= 1) v += __shfl_xor(v, o);
    return v;
}

struct Args { const float* in[21]; float* out; unsigned char* ws; };
enum { I_X = 0, I_F1N, I_F1WI, I_F1WO, I_MIXN, I_F2N, I_F2WI, I_F2WO, I_EVWI, I_EVCONV, I_EVQN, I_EVKN, I_EVWO, I_ODWI, I_ODPW, I_ODPS, I_ODSN, I_ODSW, I_ODSB, I_ODWO, I_FINN };

__device__ __forceinline__ void tr_item(const float* W, int ldw, const float* gain, bf16* WT, int dstK, int koff, int k0, int n0, int drow, LAS float* scr, int lane) {
#pragma unroll 8
    for (int i = 0; i < 32; ++i) { const int kk = 2 * i + (lane >> 5); float w = W[(size_t)(k0 + kk) * ldw + n0 + (lane & 31)]; if (gain) w *= gain[k0 + kk]; scr[kk * 33 + (lane & 31)] = w; }
    LDS_WAIT(); asm volatile("" ::: "memory");
    const int c = lane & 7;
#pragma unroll
    for (int j = 0; j < 4; ++j) { const int n = (lane >> 3) + 8 * j; const LAS float* s = scr + (8 * c) * 33 + n;
        v4u o; o.x = pk2(s[0 * 33], s[1 * 33]); o.y = pk2(s[2 * 33], s[3 * 33]); o.z = pk2(s[4 * 33], s[5 * 33]); o.w = pk2(s[6 * 33], s[7 * 33]);
        *(GAS v4u*)(WT + (size_t)(drow + n) * dstK + koff + k0 + 8 * c) = o; }
    LDS_WAIT(); asm volatile("" ::: "memory");
}

__device__ __forceinline__ void p0_prologue(const Args& a, LAS unsigned char* lds, int gw, int NGW, int gtid, int GT, int wave, int lane) {
    unsigned char* ws = a.ws;
    LAS float* scr = (LAS float*)(lds + wave * 16384);
    constexpr int N_W1 = 8 * 2816, N_W2 = 8 * 1408, N_EI = 2 * 1152, N_EO = 2 * 512, N_OI = 2 * 768, N_OO = 2 * 256, NITEMS = N_W1 + N_W2 + N_EI + N_EO + N_OI + N_OO;
    for (int it = gw; it < NITEMS; it += NGW) {
        int r = it; const float* W; const float* gain = nullptr; bf16* WT; int ldw, dstK, koff = 0, nblk, mode = 0;
        if (r < N_W1) { const int m = r / 2816; r -= m * 2816; const int l = m & 3, f2 = m >> 2; W = a.in[f2 ? I_F2WI : I_F1WI] + (size_t)l * 1024 * 5632; gain = a.in[f2 ? I_F2N : I_F1N] + l * 1024;
            WT = (bf16*)(ws + WS_W1T) + (size_t)m * 5632 * 1024; ldw = 5632; dstK = 1024; nblk = 176; mode = 1; }
        else if ((r -= N_W1) < N_W2) { const int m = r / 1408; r -= m * 1408; const int l = m & 3, f2 = m >> 2; W = a.in[f2 ? I_F2WO : I_F1WO] + (size_t)l * 2816 * 1024;
            WT = (bf16*)(ws + WS_W2T) + (size_t)m * 1024 * 2816; ldw = 1024; dstK = 2816; nblk = 32; }
        else if ((r -= N_W2) < N_EI) { const int j = r / 1152; r -= j * 1152; W = a.in[I_EVWI] + (size_t)j * 1024 * 2304; gain = a.in[I_MIXN] + (2 * j) * 1024;
            WT = (bf16*)(ws + WS_EVIN) + (size_t)j * 2304 * 1024; ldw = 2304; dstK = 1024; nblk = 72; }
        else if ((r -= N_EI) < N_EO) { const int j = r / 512; r -= j * 512; W = a.in[I_EVWO] + (size_t)j * 1024 * 1024;
            WT = (bf16*)(ws + WS_EVOUT) + (size_t)j * 1024 * 1024; ldw = 1024; dstK = 1024; nblk = 32; }
        else if ((r -= N_EO) < N_OI) { const int j = r / 768; r -= j * 768; W = a.in[I_ODWI] + (size_t)j * 1024 * 1536; gain = a.in[I_MIXN] + (2 * j + 1) * 1024;
            WT = (bf16*)(ws + WS_ODIN) + (size_t)j * 1536 * 1024; ldw = 1536; dstK = 1024; nblk = 48; }
        else { r -= N_OI; const int j = r / 256; r -= j * 256; W = a.in[I_ODWO] + (size_t)j * 1024 * 1024 + (size_t)512 * 1024;
            WT = (bf16*)(ws + WS_ODOUT) + (size_t)j * 1024 * 1024; ldw = 1024; dstK = 1024; koff = 512; nblk = 32; }
        const int kb = r / nblk, nb = r - kb * nblk, k0 = 64 * kb, n0 = 32 * nb;
        int drow = n0;
        if (mode == 1) { const int nn = n0 < 2816 ? n0 : n0 - 2816; drow = (nn >> 7) * 256 + (nn & 127) + (n0 < 2816 ? 0 : 128); }
        tr_item(W, ldw, gain, WT, dstK, koff, k0, n0, drow, scr, lane);
    }
    for (int it = gw; it < 2048; it += NGW) {
        const int j = it >> 10, g = (it >> 8) & 3, cb = (it >> 4) & 15, n = (it & 15) * 64 + lane;
        const float* pw = a.in[I_ODPW] + ((size_t)(j * 4 + g) * 128 + cb * 8) * 128; const float* sc = a.in[I_ODPS] + j * 512 + g * 128; const float* wo = a.in[I_ODWO] + (size_t)j * 1024 * 1024 + (size_t)(g * 128) * 1024 + n;
        float acc[8];
#pragma unroll
        for (int e = 0; e < 8; ++e) acc[e] = 0.f;
        for (int d = 0; d < 128; ++d) { const float wv = wo[(size_t)d * 1024] * sc[d];
#pragma unroll
            for (int e = 0; e < 8; ++e) acc[e] += pw[e * 128 + d] * wv; }
        v4u o; o.x = pk2(acc[0], acc[1]); o.y = pk2(acc[2], acc[3]); o.z = pk2(acc[4], acc[5]); o.w = pk2(acc[6], acc[7]);
        *(v4u*)((bf16*)(ws + WS_ODOUT) + (size_t)j * 1024 * 1024 + (size_t)n * 1024 + g * 128 + cb * 8) = o;
    }
    { const float* x = a.in[I_X]; bf16* xb = (bf16*)(ws + WS_XB); float* ssq0 = (float*)(ws + WS_SSQ);
      for (int m = gw; m < M; m += NGW) { const f32x4* xr = (const f32x4*)(x + (size_t)m * 1024) + lane; f32x4 v[4]; float s = 0.f;
#pragma unroll
          for (int j = 0; j < 4; ++j) { v[j] = xr[64 * j]; s += (v[j].x * v[j].x + v[j].y * v[j].y) + (v[j].z * v[j].z + v[j].w * v[j].w); }
          s = wave_sum(s); if (lane == 0) *(f32x4*)(ssq0 + 4 * (size_t)m) = (f32x4){s, 0.f, 0.f, 0.f};
          v2u* o8 = (v2u*)(xb + (size_t)m * 1024) + lane;
#pragma unroll
          for (int j = 0; j < 4; ++j) { v2u w; w.x = pk2(v[j].x, v[j].y); w.y = pk2(v[j].z, v[j].w); o8[64 * j] = w; } } }
    { const f32x4* s = (const f32x4*)a.in[I_ODSW]; v2u* o = (v2u*)(ws + WS_SGUW); for (int i = gtid; i < 2 * 4 * 128 * 128 / 4; i += GT) { const f32x4 v = s[i]; v2u w; w.x = pk2(v.x, v.y); w.y = pk2(v.z, v.w); o[i] = w; } }
}

__device__ __forceinline__ void even_prep(bf16* proj, bf16* mix, const float* qg, const float* kg, const float* convw, int gtid, int GT) {
    for (int it = gtid; it < M * 80; it += GT) {
        const int tok = it / 80, r = it - tok * 80, h = r >> 3, sub = r & 7;
        bf16* p = proj + (size_t)tok * EV_IN + 1536 + h * 64 + sub * 8;
        const v4u w = *(const v4u*)p; float x[8]; UNPACK8(x, w);
        float s = 0.f;
#pragma unroll
        for (int e = 0; e < 8; ++e) s += x[e] * x[e];
        s += __shfl_xor(s, 1); s += __shfl_xor(s, 2); s += __shfl_xor(s, 4);
        const float rs = __builtin_amdgcn_rsqf(s * (1.0f / 64.0f) + EPS);
        const float* gn = (h < 8 ? qg : kg) + sub * 8;
        const f32x4 g0 = *(const f32x4*)gn, g1 = *(const f32x4*)(gn + 4);
        const float gv[8] = {g0.x, g0.y, g0.z, g0.w, g1.x, g1.y, g1.z, g1.w};
        const int t = tok & (SEQ - 1); const float pos = (float)(sub < 4 ? (t >> 6) : (t & 63));
        const float osc = h < 8 ? attn_body::C2 : 1.0f;
        float o[8];
#pragma unroll
        for (int e = 0; e < 4; ++e) { const int j = (sub & 3) * 4 + e; const float inv = __builtin_amdgcn_exp2f(-(float)j * 0.83048202372184059f);
            const float ang = pos * inv, c = __cosf(ang), sn = __sinf(ang);
            const float x0 = x[2 * e] * rs * gv[2 * e], x1 = x[2 * e + 1] * rs * gv[2 * e + 1];
            o[2 * e] = (x0 * c - x1 * sn) * osc; o[2 * e + 1] = (x0 * sn + x1 * c) * osc; }
        v4u ow; ow.x = pk2(o[0], o[1]); ow.y = pk2(o[2], o[3]); ow.z = pk2(o[4], o[5]); ow.w = pk2(o[6], o[7]);
        *(v4u*)p = ow;
    }
    for (int it = gtid; it < M * 64; it += GT) {
        const int tok = it >> 6, c = (it & 63) * 8, t = tok & (SEQ - 1);
        const bf16* pr = proj + (size_t)tok * EV_IN + c;
        const v4u zero = (v4u){0u, 0u, 0u, 0u};
        const v4u wb = *(const v4u*)pr, wc1 = *(const v4u*)(pr + 512), wh1 = *(const v4u*)(pr + 1024);
        const v4u wc0 = t > 0 ? *(const v4u*)(pr - EV_IN + 512) : zero, wh0 = t > 0 ? *(const v4u*)(pr - EV_IN + 1024) : zero;
        const v4u wc2 = t < SEQ - 1 ? *(const v4u*)(pr + EV_IN + 512) : zero, wh2 = t < SEQ - 1 ? *(const v4u*)(pr + EV_IN + 1024) : zero;
        float gb[8], c0[8], h0[8], c1[8], h1[8], c2[8], h2[8];
        UNPACK8(gb, wb); UNPACK8(c0, wc0); UNPACK8(h0, wh0); UNPACK8(c1, wc1); UNPACK8(h1, wh1); UNPACK8(c2, wc2); UNPACK8(h2, wh2);
        const f32x4 a0 = *(const f32x4*)(convw + c), a1 = *(const f32x4*)(convw + c + 4), b0 = *(const f32x4*)(convw + 512 + c), b1 = *(const f32x4*)(convw + 512 + c + 4), d0 = *(const f32x4*)(convw + 1024 + c), d1 = *(const f32x4*)(convw + 1024 + c + 4);
        const float w0[8] = {a0.x, a0.y, a0.z, a0.w, a1.x, a1.y, a1.z, a1.w}, w1[8] = {b0.x, b0.y, b0.z, b0.w, b1.x, b1.y, b1.z, b1.w}, w2[8] = {d0.x, d0.y, d0.z, d0.w, d1.x, d1.y, d1.z, d1.w};
        float o[8];
#pragma unroll
        for (int e = 0; e < 8; ++e) o[e] = gb[e] * (w0[e] * (c0[e] * h0[e]) + w1[e] * (c1[e] * h1[e]) + w2[e] * (c2[e] * h2[e]));
        v4u ow; ow.x = pk2(o[0], o[1]); ow.y = pk2(o[2], o[3]); ow.z = pk2(o[4], o[5]); ow.w = pk2(o[6], o[7]);
        *(v4u*)(mix + (size_t)tok * 1024 + c) = ow;
    }
}

__device__ __forceinline__ void odd_pool(const bf16* proj, bf16* mix, int gtid, int GT) {
    for (int it = gtid; it < M * 64; it += GT) {
        const int tok = it >> 6, c = (it & 63) * 8, t = tok & (SEQ - 1), r = 1 << (c >> 7);
        const int lo = t - r < 0 ? 0 : t - r, hi = t + r > SEQ - 1 ? SEQ - 1 : t + r;
        const bf16* pb = proj + (size_t)(tok - t) * OD_IN + c;
        float acc[8];
#pragma unroll
        for (int e = 0; e < 8; ++e) acc[e] = 0.f;
        for (int tt = lo; tt <= hi; ++tt) { const v4u w = *(const v4u*)(pb + (size_t)tt * OD_IN); float x[8]; UNPACK8(x, w);
#pragma unroll
            for (int e = 0; e < 8; ++e) acc[e] += x[e]; }
        const float inv = 1.0f / (float)(hi - lo + 1);
        const v4u ws_ = *(const v4u*)(pb + (size_t)t * OD_IN); float xs[8]; UNPACK8(xs, ws_);
        v4u ow; ow.x = pk2(acc[0] * inv - xs[0], acc[1] * inv - xs[1]); ow.y = pk2(acc[2] * inv - xs[2], acc[3] * inv - xs[3]);
        ow.z = pk2(acc[4] * inv - xs[4], acc[5] * inv - xs[5]); ow.w = pk2(acc[6] * inv - xs[6], acc[7] * inv - xs[7]);
        *(v4u*)(mix + (size_t)tok * 1024 + c) = ow;
    }
}

__device__ __forceinline__ void sgu_chunk(int ch, const bf16* proj, const bf16* sguw, const float* norm_g, const float* b_s, bf16* mix, LAS unsigned char* lds, int tid, int lane, int wave) {
    LAS float* rstd = (LAS float*)lds;
    LAS unsigned short* vnT = (LAS unsigned short*)(lds + 512);
    const size_t row0 = (size_t)ch * 128;
    const int q = tid >> 2, part = tid & 3, fr = lane & 15, fq = lane >> 4;
    { const bf16* vp = proj + (row0 + q) * OD_IN + 1024 + part * 128; float s = 0.f;
#pragma unroll 4
      for (int i = 0; i < 16; ++i) { const v4u w = *(const v4u*)(vp + 8 * i); float x[8]; UNPACK8(x, w);
#pragma unroll
          for (int e = 0; e < 8; ++e) { const float gl = gelu_tanh(x[e]); s += gl * gl; } }
      s += __shfl_xor(s, 1); s += __shfl_xor(s, 2);
      if (part == 0) rstd[q] = __builtin_amdgcn_rsqf(s * (1.0f / 512.0f) + EPS); }
    __syncthreads();
    for (int g = 0; g < 4; ++g) {
        { const float rs = rstd[q]; const int cs = part * 32; const bf16* vp = proj + (row0 + q) * OD_IN + 1024 + g * 128 + cs; const float* ng = norm_g + g * 128 + cs;
#pragma unroll
          for (int i = 0; i < 4; ++i) { const v4u w = *(const v4u*)(vp + 8 * i); float x[8]; UNPACK8(x, w);
              const f32x4 n0 = *(const f32x4*)(ng + 8 * i), n1 = *(const f32x4*)(ng + 8 * i + 4); const float nv[8] = {n0.x, n0.y, n0.z, n0.w, n1.x, n1.y, n1.z, n1.w};
#pragma unroll
              for (int e = 0; e < 8; ++e) vnT[(cs + 8 * i + e) * 136 + q] = (unsigned short)f2bf(gelu_tanh(x[e]) * rs * nv[e]); } }
        __syncthreads();
        f32x4 acc[8];
#pragma unroll
        for (int n = 0; n < 8; ++n) acc[n] = (f32x4){0.f, 0.f, 0.f, 0.f};
        const int p = 16 * wave + fr;
#pragma unroll
        for (int ks = 0; ks < 4; ++ks) { const bf16x8 af = *(const bf16x8*)(sguw + ((size_t)(g * 128 + p) * 128 + 32 * ks + 8 * fq));
#pragma unroll
            for (int n = 0; n < 8; ++n) { const bf16x8 bfv = *(const LAS bf16x8*)(vnT + (16 * n + fr) * 136 + 32 * ks + 8 * fq);
                acc[n] = __builtin_amdgcn_mfma_f32_16x16x32_bf16(bfv, af, acc[n], 0, 0, 0); } }
        const float bias = b_s[g * 128 + p];
        const bf16* up = proj + (row0 + p) * OD_IN + 512 + g * 128 + 4 * fq; bf16* op = mix + (row0 + p) * 1024 + 512 + g * 128 + 4 * fq;
#pragma unroll
        for (int n = 0; n < 8; ++n) { const v2u uw = *(const v2u*)(up + 16 * n);
            v2u ow; ow.x = pk2(gelu_tanh(bflo(uw.x)) * (acc[n][0] + bias), gelu_tanh(bfhi(uw.x)) * (acc[n][1] + bias)); ow.y = pk2(gelu_tanh(bflo(uw.y)) * (acc[n][2] + bias), gelu_tanh(bfhi(uw.y)) * (acc[n][3] + bias));
            *(v2u*)(op + 16 * n) = ow; }
        __syncthreads();
    }
}

struct Ctx { int tid, lane, wave, G, bx, vcu, gw, NGW, gtid, GT; };
__device__ __forceinline__ Ctx mkctx() {
    Ctx c; int t = threadIdx.x; asm volatile("" : "+v"(t)); int g = gridDim.x, b = blockIdx.x; asm volatile("" : "+s"(g), "+s"(b));
    c.tid = t; c.lane = t & 63; c.wave = __builtin_amdgcn_readfirstlane(t >> 6); c.G = g; c.bx = b;
    c.vcu = (g % 8 == 0) ? (b % 8) * (g / 8) + b / 8 : b;
    c.gw = c.vcu * NWAVES + c.wave; c.NGW = g * NWAVES; c.gtid = b * (NWAVES * 64) + t; c.GT = g * NWAVES * 64; return c;
}
__device__ __forceinline__ const Args* kargs() { auto p = __builtin_amdgcn_kernarg_segment_ptr(); asm volatile("" : "+s"(p)); return (const Args*)p; }
#define GRID_SYNC() do { asm volatile("s_waitcnt vmcnt(0) lgkmcnt(0)" ::: "memory"); __syncthreads(); cg::this_grid().sync(); __builtin_amdgcn_fence(__ATOMIC_ACQUIRE, "agent"); asm volatile("s_waitcnt vmcnt(0)" ::: "memory"); } while (0)

__global__ void __launch_bounds__(NWAVES * 64, 2) mega_fwd(Args args_unused) {
    extern __shared__ __attribute__((aligned(16))) unsigned char lds_raw[];
    LAS unsigned char* lds = (LAS unsigned char*)lds_raw;
#ifndef NO_P0
    { const Ctx c = mkctx(); const Args* A = kargs(); p0_prologue(*A, lds, c.gw, c.NGW, c.gtid, c.GT, c.wave, c.lane); }
#endif
    GRID_SYNC();

    for (int j = 0; j < 12; ++j) {
        const int l = j / 3, kind = j - 3 * l;
        if (kind != 1) {
            const int wi = (kind == 2 ? 4 : 0) + l;
#ifndef NO_G1
            { const Ctx c = mkctx(); const Args* A = kargs(); unsigned char* ws = A->ws;
              pg8::Gemm g{(const bf16*)(ws + WS_XB), (const bf16*)(ws + WS_W1T) + (size_t)wi * 5632 * 1024, M, 2 * DFF, DMODEL}; pg8::StaticOrder S; S.init(M, 2 * DFF, c.G, c.bx);
              pg8::EpiSwiGLU E{(bf16*)(ws + WS_ACT), DFF, (const float*)(ws + WS_SSQ) + (size_t)j * M * 4};
              pg8::gemm_phase<pg8::EpiSwiGLU, pg8::StaticOrder, true, true>(lds, g, S, E); }
#endif
            GRID_SYNC();
        } else {
            const int jj = l >> 1; const bool even = (l & 1) == 0;
#ifndef NO_G3
            { const Ctx c = mkctx(); const Args* A = kargs(); unsigned char* ws = A->ws; const int N = even ? EV_IN : OD_IN;
              const bf16* wt = even ? (const bf16*)(ws + WS_EVIN) + (size_t)jj * EV_IN * 1024 : (const bf16*)(ws + WS_ODIN) + (size_t)jj * OD_IN * 1024;
              pg8::Gemm g{(const bf16*)(ws + WS_XB), wt, M, N, DMODEL}; pg8::StaticOrder S; S.init(M, N, c.G, c.bx);
              pg8::EpiRowScale E{(bf16*)(ws + WS_PROJ), N, (const float*)(ws + WS_SSQ) + (size_t)j * M * 4};
              pg8::gemm_phase<pg8::EpiRowScale, pg8::StaticOrder, true, true>(lds, g, S, E); }
#endif
            GRID_SYNC();
            if (even) {
#ifndef NO_PREP
                { const Ctx c = mkctx(); const Args* A = kargs(); unsigned char* ws = A->ws;
                  even_prep((bf16*)(ws + WS_PROJ), (bf16*)(ws + WS_MIX), A->in[I_EVQN] + jj * 64, A->in[I_EVKN] + jj * 64, A->in[I_EVCONV] + jj * 3 * 512, c.gtid, c.GT); }
#endif
                GRID_SYNC();
#ifndef NO_ATTN
                { const Ctx c = mkctx(); const Args* A = kargs(); unsigned char* ws = A->ws; const attn_body::bf16* PROJ = (const attn_body::bf16*)(ws + WS_PROJ); attn_body::bf16* MIX = (attn_body::bf16*)(ws + WS_MIX);
                  for (int ui = c.vcu; ui < 1024; ui += c.G) {
                      const int bh = ui >> 3, qb = ui & 7, b = bh >> 3, h = bh & 7, kvh = h >> 2;
                      attn_body::attn_unit<8>(b, qb, PROJ + 1536 + h * 64, PROJ + 2048 + kvh * 64, PROJ + 2176 + kvh * 64, MIX + 512 + h * 64, (char*)lds_raw);
                  } }
#endif
            } else {
#ifndef NO_POOL
                { const Ctx c = mkctx(); const Args* A = kargs(); unsigned char* ws = A->ws; odd_pool((const bf16*)(ws + WS_PROJ), (bf16*)(ws + WS_MIX), c.gtid, c.GT); }
#endif
#ifndef NO_SGU
                { const Ctx c = mkctx(); const Args* A = kargs(); unsigned char* ws = A->ws;
                  for (int ch = c.vcu; ch < 256; ch += c.G)
                      sgu_chunk(ch, (const bf16*)(ws + WS_PROJ), (const bf16*)(ws + WS_SGUW) + (size_t)jj * 4 * 128 * 128, A->in[I_ODSN] + jj * 512, A->in[I_ODSB] + jj * 512, (bf16*)(ws + WS_MIX), lds, c.tid, c.lane, c.wave); }
#endif
            }
            GRID_SYNC();
        }
#ifndef NO_G2
        { const Ctx c = mkctx(); const Args* A = kargs(); unsigned char* ws = A->ws; float* out = A->out; const bool ffn = kind != 1; const int jj = l >> 1;
          const bf16* wt = ffn ? (const bf16*)(ws + WS_W2T) + (size_t)((kind == 2 ? 4 : 0) + l) * 1024 * 2816 : ((l & 1) == 0 ? (const bf16*)(ws + WS_EVOUT) : (const bf16*)(ws + WS_ODOUT)) + (size_t)jj * 1024 * 1024;
          pg8::Gemm g{ffn ? (const bf16*)(ws + WS_ACT) : (const bf16*)(ws + WS_MIX), wt, M, DMODEL, ffn ? DFF : DMODEL}; pg8::StaticOrder S; S.init(M, DMODEL, c.G, c.bx);
          pg8::EpiResid E{(j == 0) ? A->in[I_X] : out, out, (bf16*)(ws + WS_XB), (float*)(ws + WS_SSQ) + (size_t)(j + 1) * M * 4, ffn ? 0.5f : 1.0f};
          pg8::gemm_phase<pg8::EpiResid, pg8::StaticOrder, true, true>(lds, g, S, E); }
#endif
        GRID_SYNC();
    }
    { const Ctx c = mkctx(); const Args* A = kargs(); float* out = A->out; const float* ssq = (const float*)(A->ws + WS_SSQ) + (size_t)12 * M * 4; const f32x4* gf = (const f32x4*)A->in[I_FINN];
      for (int m = c.gw; m < M; m += c.NGW) { const float rs = pg8::row_rs(ssq, m); f32x4* xr = (f32x4*)(out + (size_t)m * 1024) + c.lane;
#pragma unroll
          for (int q = 0; q < 4; ++q) xr[64 * q] = xr[64 * q] * rs * gf[c.lane + 64 * q]; } }
}

extern "C" void kernel_launch(void* const* d_in, const int* in_sizes, int n_in, void* d_out, int out_size, void* d_ws, size_t ws_size, hipStream_t stream) {
    static int grid = 0;
    if (grid == 0) {
        if (n_in != 21 || in_sizes[0] != M * DMODEL || out_size != M * DMODEL || ws_size < WS_END) { fprintf(stderr, "kernel_launch: unexpected shapes (n_in %d, in0 %d, out %d, ws %zu)\n", n_in, n_in > 0 ? in_sizes[0] : -1, out_size, ws_size); grid = -1; return; }
        int dev = 0, cus = 0, per_cu = 0;
        if (hipGetDevice(&dev) != hipSuccess || hipDeviceGetAttribute(&cus, hipDeviceAttributeMultiprocessorCount, dev) != hipSuccess) { grid = -1; return; }
        if (hipFuncSetAttribute((const void*)mega_fwd, hipFuncAttributeMaxDynamicSharedMemorySize, LDS_BYTES) != hipSuccess) { fprintf(stderr, "kernel_launch: hipFuncSetAttribute failed\n"); grid = -1; return; }
        if (hipOccupancyMaxActiveBlocksPerMultiprocessor(&per_cu, (const void*)mega_fwd, NWAVES * 64, LDS_BYTES) != hipSuccess || per_cu < 1) { fprintf(stderr, "kernel_launch: occupancy query says %d\n", per_cu); per_cu = 1; }
        (void)hipGetLastError();
        grid = cus * per_cu;
    }
    if (grid < 0) return;
    Args a{};
    for (int i = 0; i < 21; ++i) a.in[i] = (const float*)d_in[i];
    a.out = (float*)d_out; a.ws = (unsigned char*)d_ws;
    void* params[] = {&a};
    hipError_t e = hipLaunchCooperativeKernel((const void*)mega_fwd, dim3(grid), dim3(NWAVES * 64), params, LDS_BYTES, stream);
    if (e != hipSuccess) fprintf(stderr, "kernel_launch: cooperative launch failed: %s (grid %d)\n", hipGetErrorString(e), grid);
}
```

```cpp
#include <hip/hip_runtime.h>
#include <hip/hip_cooperative_groups.h>
#include <hip/hip_bf16.h>
#include <cstdio>
#include <cstdint>
#include <cmath>
namespace pg8 {
#define PG8_LAS __attribute__((address_space(3)))
typedef unsigned short bf16_t;
typedef short bf16x8 __attribute__((ext_vector_type(8)));
typedef float f32x4 __attribute__((ext_vector_type(4)));
typedef unsigned u32x4 __attribute__((ext_vector_type(4)));
constexpr int BM = 256, BK = 64, HALF = 128, HTB = HALF * BK * 2  , STAGE_BYTES = 8 * HTB, NXCD = 8, WGM = 8;

__host__ __device__ __forceinline__ int lds_byte(int r, int c) { const int st = (r >> 4) * 2 + (c >> 5), rr = r & 15, cc = c & 31, ob = rr * 64 + cc * 2; return st * 1024 + (ob ^ (((ob >> 9) & 1) << 5)); }
__host__ __device__ __forceinline__ void stage_rc(int b, int& R, int& C) { const int st = b / 1024, sb = b % 1024, swz = sb ^ (((sb >> 9) & 1) << 5); R = (st >> 1) * 16 + swz / 64; C = (st & 1) * 32 + (swz % 64) / 2; }
__host__ __device__ __forceinline__ int perm32(int rho) { const int n = rho >> 4, i = rho & 15; return 8 * (i >> 2) + 4 * n + (i & 3); }

struct Unit { int pm, pn; };
struct Gemm { const bf16_t* A; const bf16_t* Bt; int M, N, K; };

struct StaticOrder {
    int nM, nN, nwg, G, c;
    __host__ __device__ void init(int M, int N, int G_, int c_) { nM = M / BM; nN = N / BM; nwg = nM * nN; G = G_; c = c_; }
    __host__ __device__ bool next(int i, Unit& u) const {
        const long L = (long)i * G + c; if (L >= nwg) return false;
        int wgid = (int)L; { const int q = nwg / NXCD, r = nwg % NXCD, xcd = wgid % NXCD, off = wgid / NXCD; wgid = (xcd < r ? xcd * (q + 1) : r * (q + 1) + (xcd - r) * q) + off; }
        const int nig = WGM * nN, gid = wgid / nig, fm = gid * WGM, gsz = (nM - fm) < WGM ? (nM - fm) : WGM;
        u.pm = fm + ((wgid % nig) % gsz); u.pn = (wgid % nig) / gsz; return true;
    }
    __device__ __forceinline__ void a_ready(const Unit&) const {}
    __device__ __forceinline__ void done(const Unit&) const {}
};
__device__ __forceinline__ unsigned cvt_pk_bf16(float lo, float hi) { unsigned r; asm volatile("v_cvt_pk_bf16_f32 %0, %1, %2" : "=v"(r) : "v"(lo), "v"(hi)); return r; }
typedef float f32x2 __attribute__((ext_vector_type(2)));
__device__ __forceinline__ float row_rs(const float* ssq, int row) { const f32x4 p = *(const f32x4*)(ssq + 4 * (size_t)row); return __builtin_amdgcn_rsqf(((p[0] + p[1]) + (p[2] + p[3])) * (1.0f / 1024.0f) + 1e-6f); }
__device__ __forceinline__ float silu_f(float g) { return g * __builtin_amdgcn_rcpf(1.0f + __builtin_amdgcn_exp2f(-1.4426950408889634f * g)); }
struct EpiSwiGLU {
    static constexpr bool PERM = true, AFTER_DRAIN = false;
    bf16_t* O; int ldc; const float* ssq;
    __device__ __forceinline__ void operator()(const f32x4 (&acc)[2][2][4][2], const Unit& u, int wr, int wc, int fr, int fq) const {
        const int row0 = u.pm * BM + wr * 64 + fr, col0 = u.pn * HALF + wc * 32 + 8 * fq;
#pragma unroll
        for (int ai = 0; ai < 2; ++ai)
#pragma unroll
            for (int m = 0; m < 4; ++m) { const int row = row0 + ai * HALF + m * 16; const float rs = row_rs(ssq, row);
                const f32x4 g0 = acc[ai][0][m][0] * rs, g1 = acc[ai][0][m][1] * rs, u0 = acc[ai][1][m][0] * rs, u1 = acc[ai][1][m][1] * rs;
                u32x4 w; w.x = cvt_pk_bf16(silu_f(g0[0]) * u0[0], silu_f(g0[1]) * u0[1]); w.y = cvt_pk_bf16(silu_f(g0[2]) * u0[2], silu_f(g0[3]) * u0[3]);
                w.z = cvt_pk_bf16(silu_f(g1[0]) * u1[0], silu_f(g1[1]) * u1[1]); w.w = cvt_pk_bf16(silu_f(g1[2]) * u1[2], silu_f(g1[3]) * u1[3]);
                *(u32x4*)(O + (size_t)row * ldc + col0) = w; }
    }
};
struct EpiRowScale {
    static constexpr bool PERM = true, AFTER_DRAIN = false;
    bf16_t* O; int ldc; const float* ssq;
    __device__ __forceinline__ void operator()(const f32x4 (&acc)[2][2][4][2], const Unit& u, int wr, int wc, int fr, int fq) const {
        const int row0 = u.pm * BM + wr * 64 + fr, col0 = u.pn * BM + wc * 32 + 8 * fq;
#pragma unroll
        for (int ai = 0; ai < 2; ++ai)
#pragma unroll
            for (int m = 0; m < 4; ++m) { const int row = row0 + ai * HALF + m * 16; const float rs = row_rs(ssq, row); bf16_t* rowp = O + (size_t)row * ldc + col0;
#pragma unroll
                for (int bj = 0; bj < 2; ++bj) { const f32x4 v0 = acc[ai][bj][m][0] * rs, v1 = acc[ai][bj][m][1] * rs;
                    u32x4 w; w.x = cvt_pk_bf16(v0[0], v0[1]); w.y = cvt_pk_bf16(v0[2], v0[3]); w.z = cvt_pk_bf16(v1[0], v1[1]); w.w = cvt_pk_bf16(v1[2], v1[3]);
                    *(u32x4*)(rowp + bj * HALF) = w; } }
    }
};
struct EpiResid {
    static constexpr bool PERM = false, AFTER_DRAIN = false;
    const float* base; float* out; bf16_t* xb; float* ssq_out; float alpha;
    __device__ __forceinline__ void operator()(const f32x4 (&acc)[2][2][4][2], const Unit& u, int wr, int wc, int fr, int fq) const {
        typedef unsigned u32x2v __attribute__((ext_vector_type(2)));
        PG8_LAS float* P = (PG8_LAS float*)(STAGE_BYTES);
        const int row0 = u.pm * BM + wr * 64 + fr, col0 = u.pn * BM + wc * 32 + 4 * fq;
#pragma unroll
        for (int ai = 0; ai < 2; ++ai)
#pragma unroll
            for (int m = 0; m < 4; ++m) { const int row = row0 + ai * HALF + m * 16; const size_t off = (size_t)row * 1024 + col0; float s = 0.f;
#pragma unroll
                for (int bj = 0; bj < 2; ++bj)
#pragma unroll
                    for (int n = 0; n < 2; ++n) { const size_t o2 = off + bj * HALF + n * 16; const f32x4 b = *(const f32x4*)(base + o2); const f32x4 o = b + acc[ai][bj][m][n] * alpha;
                        *(f32x4*)(out + o2) = o; s += (o[0] * o[0] + o[1] * o[1]) + (o[2] * o[2] + o[3] * o[3]);
                        u32x2v w; w.x = cvt_pk_bf16(o[0], o[1]); w.y = cvt_pk_bf16(o[2], o[3]); *(u32x2v*)(xb + o2) = w; }
                s += __shfl_xor(s, 16); s += __shfl_xor(s, 32);
                if (fq == 0) P[(ai * HALF + wr * 64 + m * 16 + fr) * 4 + wc] = s;
                if (m & 1) asm volatile("" ::: "memory"); }
        asm volatile("s_waitcnt lgkmcnt(0)" ::: "memory"); __builtin_amdgcn_s_barrier(); asm volatile("" ::: "memory");
        int t = threadIdx.x; asm volatile("" : "+v"(t));
        if (t < 256) { const f32x4 p = *(const PG8_LAS f32x4*)(P + 4 * t); ssq_out[(size_t)(u.pm * BM + t) * 4 + u.pn] = (p[0] + p[1]) + (p[2] + p[3]); }
    }
};

template <class Epi, class Sched, bool ALIGN_EPI = false, bool SP2 = false>
__device__ __forceinline__ void gemm_phase(PG8_LAS unsigned char* lds, const Gemm g, const Sched& S, const Epi& E) {
    int tid_ = threadIdx.x; asm volatile("" : "+v"(tid_));
    const int tid = tid_, wid = __builtin_amdgcn_readfirstlane(tid >> 6), lane = tid & 63, wr = wid >> 2, wc = wid & 3, fr = lane & 15, fq = lane >> 4;
    const int K = g.K, nt = K / BK;
    unsigned voffA[2], voffB[2];
#pragma unroll
    for (int i = 0; i < 2; ++i) { int R, C; stage_rc(tid * 16 + i * 8192, R, C); const int Rb = Epi::PERM ? ((R & ~31) + perm32(R & 31)) : R;
        voffA[i] = (unsigned)(R * K + C) * 2u; voffB[i] = (unsigned)(Rb * K + C) * 2u; }
    const size_t kstep = (size_t)(BK * 2);
    const size_t hstep = (size_t)HALF * K * 2;
    const size_t tstep = 2 * hstep;
    const unsigned ldsw = (unsigned)wid * 1024u;
    const int aoff = lds_byte(wr * 64 + fr, fq * 8), boff = lds_byte(wc * 32 + fr, fq * 8);
#define PG8_SA(b, h) (((b) * 2 + (h)) * HTB)
#define PG8_SB(b, h) ((4 + (b) * 2 + (h)) * HTB)
#define PG8_STAGE(bufoff, gbase, voff) do { _Pragma("unroll") for (int _i = 0; _i < 2; ++_i) \
        __builtin_amdgcn_global_load_lds((const unsigned*)((const char*)(gbase) + (voff)[_i]), (PG8_LAS unsigned*)(lds + (bufoff) + ldsw + _i * 8192), 16, 0, 0); } while (0)
#define PG8_LDA(dst, b, h) do { _Pragma("unroll") for (int m = 0; m < 4; ++m) _Pragma("unroll") for (int k = 0; k < 2; ++k) dst[m][k] = *(const PG8_LAS bf16x8*)(lds + PG8_SA(b, h) + aoff + m * 2048 + k * 1024); } while (0)
#define PG8_LDB(dst, b, h) do { _Pragma("unroll") for (int n = 0; n < 2; ++n) _Pragma("unroll") for (int k = 0; k < 2; ++k) dst[n][k] = *(const PG8_LAS bf16x8*)(lds + PG8_SB(b, h) + boff + n * 2048 + k * 1024); } while (0)
#define PG8_MMA(ai, bj, At, Bt) do { __builtin_amdgcn_s_setprio(1); _Pragma("unroll") for (int m = 0; m < 4; ++m) _Pragma("unroll") for (int n = 0; n < 2; ++n) _Pragma("unroll") for (int k = 0; k < 2; ++k) \
        acc[ai][bj][m][n] = __builtin_amdgcn_mfma_f32_16x16x32_bf16(Bt[n][k], At[m][k], acc[ai][bj][m][n], 0, 0, 0); __builtin_amdgcn_s_setprio(0); } while (0)
#define PG8_WAIT_V(n) asm volatile("s_waitcnt vmcnt(" #n ")" ::: "memory")
#define PG8_WAIT_L(n) asm volatile("s_waitcnt lgkmcnt(" #n ")" ::: "memory")
#define PG8_BAR __builtin_amdgcn_s_barrier()
#define PG8_SCHED __builtin_amdgcn_sched_barrier(0)
    Unit cur, nxt; int ui = 0;
    if (!S.next(0, cur)) return;
    f32x4 acc[2][2][4][2];
#pragma unroll
    for (int a = 0; a < 2; ++a)
#pragma unroll
        for (int b = 0; b < 2; ++b)
#pragma unroll
            for (int m = 0; m < 4; ++m)
#pragma unroll
                for (int n = 0; n < 2; ++n) acc[a][b][m][n] = (f32x4){0.f, 0.f, 0.f, 0.f};
    bf16x8 At[4][2], B0[2][2], B1[2][2];
    const char* cA = (const char*)g.A + (size_t)cur.pm * tstep; const char* cB = (const char*)g.Bt + (size_t)cur.pn * tstep;
    S.a_ready(cur);
    if constexpr (SP2) {
        PG8_STAGE(PG8_SB(0, 0), cB, voffB); PG8_STAGE(PG8_SB(0, 1), cB + hstep, voffB); PG8_STAGE(PG8_SA(0, 0), cA, voffA); PG8_STAGE(PG8_SA(0, 1), cA + hstep, voffA);
        if (wr == 1) PG8_BAR;
        PG8_WAIT_V(2); PG8_BAR;
        PG8_STAGE(PG8_SB(1, 0), cB + kstep, voffB); PG8_STAGE(PG8_SA(1, 0), cA + kstep, voffA); PG8_STAGE(PG8_SB(1, 1), cB + hstep + kstep, voffB);
        PG8_WAIT_V(6); PG8_BAR;
    } else {
        PG8_STAGE(PG8_SB(0, 0), cB, voffB); PG8_STAGE(PG8_SA(0, 0), cA, voffA); PG8_STAGE(PG8_SB(0, 1), cB + hstep, voffB); PG8_STAGE(PG8_SA(0, 1), cA + hstep, voffA);
        if (wr == 1) PG8_BAR;
        PG8_WAIT_V(4); PG8_BAR;
        PG8_STAGE(PG8_SB(1, 0), cB + kstep, voffB); PG8_STAGE(PG8_SA(1, 0), cA + kstep, voffA); PG8_STAGE(PG8_SB(1, 1), cB + hstep + kstep, voffB);
        PG8_WAIT_V(6); PG8_BAR;
    }
    for (;;) {
        const bool has_next = S.next(ui + 1, nxt);
        const char* nA = has_next ? (const char*)g.A + (size_t)nxt.pm * tstep : cA; const char* nB = has_next ? (const char*)g.Bt + (size_t)nxt.pn * tstep : cB;
        for (int t = 0; t < nt; t += 2) {
            const bool last = (t == nt - 2);
            const char* a1 = cA + (size_t)(t + 1) * kstep;
            const char* a2 = last ? nA : cA + (size_t)(t + 2) * kstep; const char* b2 = last ? nB : cB + (size_t)(t + 2) * kstep;
            const char* a3 = a2 + kstep; const char* b3 = b2 + kstep;
            if (last && has_next) S.a_ready(nxt);
            if constexpr (SP2) {
            PG8_LDB(B0, 0, 0); PG8_LDB(B1, 0, 1); PG8_SCHED; PG8_LDA(At, 0, 0); PG8_STAGE(PG8_SA(1, 1), a1 + hstep, voffA);
            PG8_WAIT_V(8); PG8_WAIT_L(0); PG8_BAR; PG8_MMA(0, 0, At, B0); PG8_MMA(0, 1, At, B1); PG8_BAR; PG8_SCHED;
            PG8_LDA(At, 0, 1); PG8_STAGE(PG8_SB(0, 0), b2, voffB); PG8_STAGE(PG8_SB(0, 1), b2 + hstep, voffB); PG8_STAGE(PG8_SA(0, 0), a2, voffA);
            PG8_WAIT_V(8); PG8_WAIT_L(0); PG8_BAR; PG8_MMA(1, 0, At, B0); PG8_MMA(1, 1, At, B1); PG8_BAR; PG8_SCHED;
            PG8_LDB(B0, 1, 0); PG8_LDB(B1, 1, 1); PG8_SCHED; PG8_LDA(At, 1, 0); PG8_STAGE(PG8_SA(0, 1), a2 + hstep, voffA);
            PG8_WAIT_V(8); PG8_WAIT_L(0); PG8_BAR; PG8_MMA(0, 0, At, B0); PG8_MMA(0, 1, At, B1); PG8_BAR; PG8_SCHED;
            PG8_LDA(At, 1, 1); PG8_STAGE(PG8_SB(1, 0), b3, voffB); PG8_STAGE(PG8_SB(1, 1), b3 + hstep, voffB); PG8_STAGE(PG8_SA(1, 0), a3, voffA);
            PG8_WAIT_V(8); PG8_WAIT_L(0); PG8_BAR; PG8_MMA(1, 0, At, B0); PG8_MMA(1, 1, At, B1); PG8_BAR; PG8_SCHED;
            } else {
            PG8_LDB(B0, 0, 0); PG8_SCHED; PG8_LDA(At, 0, 0); PG8_STAGE(PG8_SA(1, 1), a1 + hstep, voffA);
            PG8_WAIT_L(8); PG8_BAR; PG8_WAIT_L(0); PG8_MMA(0, 0, At, B0); PG8_BAR; PG8_SCHED;
            PG8_LDB(B1, 0, 1); PG8_STAGE(PG8_SB(0, 0), b2, voffB);
            PG8_BAR; PG8_WAIT_L(0); PG8_MMA(0, 1, At, B1); PG8_BAR;
            PG8_LDA(At, 0, 1); PG8_STAGE(PG8_SA(0, 0), a2, voffA);
            PG8_BAR; PG8_WAIT_L(0); PG8_MMA(1, 0, At, B0); PG8_BAR; PG8_SCHED;
            PG8_STAGE(PG8_SB(0, 1), b2 + hstep, voffB);
            PG8_WAIT_V(6); PG8_BAR; PG8_MMA(1, 1, At, B1); PG8_BAR;
            PG8_LDB(B0, 1, 0); PG8_SCHED; PG8_LDA(At, 1, 0); PG8_STAGE(PG8_SA(0, 1), a2 + hstep, voffA);
            PG8_WAIT_L(8); PG8_BAR; PG8_WAIT_L(0); PG8_MMA(0, 0, At, B0); PG8_BAR; PG8_SCHED;
            PG8_LDB(B1, 1, 1); PG8_STAGE(PG8_SB(1, 0), b3, voffB);
            PG8_BAR; PG8_WAIT_L(0); PG8_MMA(0, 1, At, B1); PG8_BAR;
            PG8_LDA(At, 1, 1); PG8_STAGE(PG8_SA(1, 0), a3, voffA);
            PG8_BAR; PG8_WAIT_L(0); PG8_MMA(1, 0, At, B0); PG8_BAR; PG8_SCHED;
            PG8_STAGE(PG8_SB(1, 1), b3 + hstep, voffB);
            PG8_WAIT_V(6); PG8_BAR; PG8_MMA(1, 1, At, B1); PG8_BAR;
            }
        }
        if constexpr (ALIGN_EPI) { if (wr == 0) PG8_BAR; }
        if constexpr (!Epi::AFTER_DRAIN) { E(acc, cur, wr, wc, fr, fq); S.done(cur); }
        if (!has_next) break;
#pragma unroll
        for (int a = 0; a < 2; ++a)
#pragma unroll
            for (int b = 0; b < 2; ++b)
#pragma unroll
                for (int m = 0; m < 4; ++m)
#pragma unroll
                    for (int n = 0; n < 2; ++n) acc[a][b][m][n] = (f32x4){0.f, 0.f, 0.f, 0.f};
        cur = nxt; cA = nA; cB = nB; ++ui;
        if constexpr (ALIGN_EPI) { if (wr == 1) PG8_BAR; }
    }
    PG8_WAIT_V(0);
    if constexpr (!ALIGN_EPI) { if (wr == 0) PG8_BAR; }
    PG8_BAR;
    if constexpr (Epi::AFTER_DRAIN) { E.fused(acc, cur, wr, wc, fr, fq, lds, wid, lane); S.done(cur); }
#undef PG8_SA
#undef PG8_SB
#undef PG8_STAGE
#undef PG8_LDA
#undef PG8_LDB
#undef PG8_MMA
#undef PG8_WAIT_V
#undef PG8_WAIT_L
#undef PG8_BAR
#undef PG8_SCHED
}
}
namespace attn_body {
using bf16=__hip_bfloat16;
using bf16x8=__attribute__((ext_vector_type(8)))short;
using s16x4=__attribute__((ext_vector_type(4)))short;
using f32x16=__attribute__((ext_vector_type(16)))float;
using u32x4=__attribute__((ext_vector_type(4)))unsigned;
constexpr int BATCH=16,NHEAD=8,SEQ=2048,D=64,PQ=2304,PO=1024;
constexpr int NW=8,QBLK=32,QB=QBLK*NW,KVBLK=64,NQB=SEQ/QB;
constexpr int ATTN_UNIT_ROWS=QB;
__device__ __forceinline__ int crow(int r,int hi){return (r&3)+8*(r>>2)+4*hi;}
#define SBAR() __builtin_amdgcn_sched_barrier(0)
__device__ __forceinline__ void cmask(f32x16&p0,f32x16&p1,int jb,int qrel,int hi){
  const float NEG=-INFINITY; int kb=64*jb+4*hi;
  #pragma unroll
  for(int r=0;r<16;++r){int kv=kb+(r&3)+8*(r>>2); if(kv>qrel)p0[r]=NEG; if(kv+32>qrel)p1[r]=NEG;}
}

constexpr int NSLOT=3, SLOTB=8192;
constexpr int LDS_K=0, LDS_V=NSLOT*SLOTB, LDS_WS=2*NSLOT*SLOTB, LDS_OST=LDS_WS+NW*64*4, LDS_BYTES=LDS_OST+NW*4096;
constexpr float C2=0.125f*1.4426950408889634f;
__device__ __forceinline__ void glds16(const void*gsrc,unsigned lds_dst){unsigned keep;
  asm volatile("s_mov_b32 %0, m0\n\ts_mov_b32 m0, %2\n\ts_nop 0\n\tglobal_load_lds_dwordx4 %1, off\n\ts_mov_b32 m0, %0":"=&s"(keep):"v"(gsrc),"s"(lds_dst):"memory");}
__device__ __forceinline__ float max3f(float a,float b,float c){float r;asm("v_max3_f32 %0, %1, %2, %3":"=v"(r):"v"(a),"v"(b),"v"(c));return r;}
__device__ __forceinline__ float max2f(float a,float b){float r;asm("v_max_f32_e32 %0, %1, %2":"=v"(r):"v"(a),"v"(b));return r;}
__device__ __forceinline__ float fadd_s(float a,float b){float r;asm("v_add_f32_e32 %0, %1, %2":"=v"(r):"v"(a),"v"(b));return r;}
__device__ __forceinline__ float fsub_s(float a,float b){float r;asm("v_sub_f32_e32 %0, %1, %2":"=v"(r):"v"(a),"v"(b));return r;}
typedef float f32x2_t __attribute__((ext_vector_type(2))); typedef __bf16 bf16x2_t __attribute__((ext_vector_type(2)));
__device__ __forceinline__ unsigned cvtpk_s(float lo,float hi){f32x2_t v={lo,hi};bf16x2_t b=__builtin_convertvector(v,bf16x2_t);return __builtin_bit_cast(unsigned,b);}
#define WAIT_BAR(N) asm volatile("s_waitcnt vmcnt(" #N ") lgkmcnt(0)\n\ts_barrier":::"memory")

__device__ __forceinline__ void qkt(f32x16&p0,f32x16&p1,const char*Kslot,const bf16x8*qr,const f32x16&negm,int r32,int hi){
  const char*kb=Kslot+hi*1024+r32*16;
  #pragma unroll
  for(int d0=0;d0<4;++d0){
    const bf16x8 b0=*reinterpret_cast<const bf16x8*>(kb+d0*2048);
    const bf16x8 b1=*reinterpret_cast<const bf16x8*>(kb+d0*2048+512);
    if(d0==0){p0=__builtin_amdgcn_mfma_f32_32x32x16_bf16(b0,qr[0],negm,0,0,0);p1=__builtin_amdgcn_mfma_f32_32x32x16_bf16(b1,qr[0],negm,0,0,0);}
    else{p0=__builtin_amdgcn_mfma_f32_32x32x16_bf16(b0,qr[d0],p0,0,0,0);p1=__builtin_amdgcn_mfma_f32_32x32x16_bf16(b1,qr[d0],p1,0,0,0);}}
}
typedef __attribute__((address_space(3))) const char* lds_cptr;
typedef short v4i16_t __attribute__((ext_vector_type(4)));
__device__ __forceinline__ void kload8(bf16x8*kf,lds_cptr kp){
  kf[0]=*(const __attribute__((address_space(3))) bf16x8*)(kp);      kf[1]=*(const __attribute__((address_space(3))) bf16x8*)(kp+512);
  kf[2]=*(const __attribute__((address_space(3))) bf16x8*)(kp+2048); kf[3]=*(const __attribute__((address_space(3))) bf16x8*)(kp+2560);
  kf[4]=*(const __attribute__((address_space(3))) bf16x8*)(kp+4096); kf[5]=*(const __attribute__((address_space(3))) bf16x8*)(kp+4608);
  kf[6]=*(const __attribute__((address_space(3))) bf16x8*)(kp+6144); kf[7]=*(const __attribute__((address_space(3))) bf16x8*)(kp+6656);
}
__device__ __forceinline__ void kload2(bf16x8*kf,lds_cptr kp,int j){ kf[2*j]=*(const __attribute__((address_space(3))) bf16x8*)(kp+j*2048); kf[2*j+1]=*(const __attribute__((address_space(3))) bf16x8*)(kp+j*2048+512); }
__device__ __forceinline__ s16x4 vtr(lds_cptr p){ return __builtin_bit_cast(s16x4,__builtin_amdgcn_ds_read_tr16_b64_v4i16((__attribute__((address_space(3))) v4i16_t*)p)); }
__device__ __forceinline__ float rowmax(const f32x16&p0,const f32x16&p1){
  float a=max3f(p0[0],p0[1],p1[0]),b=max3f(p0[2],p0[3],p1[1]);a=max3f(a,p1[2],p1[3]);
  #pragma unroll
  for(int r=4;r<16;r+=4){a=max3f(a,p0[r],p0[r+1]);b=max3f(b,p0[r+2],p0[r+3]);a=max3f(a,p1[r],p1[r+1]);b=max3f(b,p1[r+2],p1[r+3]);}
  const float m=max2f(a,b);
  auto rr=__builtin_amdgcn_permlane32_swap(__float_as_uint(m),__float_as_uint(m),false,false);
  return max2f(__uint_as_float(rr[0]),__uint_as_float(rr[1]));
}
__device__ __forceinline__ void pv(f32x16*o,int vb,bf16x8 pa0,bf16x8 pa1,bf16x8 pa2,bf16x8 pa3){
  #pragma unroll
  for(int d0=0;d0<2;++d0){s16x4 lo[4],hi[4];
    #pragma unroll
    for(int ks=0;ks<4;++ks){
      asm volatile("ds_read_b64_tr_b16 %0,%1 offset:%c2":"=&v"(lo[ks]):"v"(vb),"i"(d0*4096+ks*1024):"memory");
      asm volatile("ds_read_b64_tr_b16 %0,%1 offset:%c2":"=&v"(hi[ks]):"v"(vb),"i"(d0*4096+ks*1024+512):"memory");}
    asm volatile("s_waitcnt lgkmcnt(0)":::"memory");SBAR();
    #define PK(k) (bf16x8){lo[k][0],lo[k][1],lo[k][2],lo[k][3],hi[k][0],hi[k][1],hi[k][2],hi[k][3]}
    o[d0]=__builtin_amdgcn_mfma_f32_32x32x16_bf16(pa0,PK(0),o[d0],0,0,0);
    o[d0]=__builtin_amdgcn_mfma_f32_32x32x16_bf16(pa1,PK(1),o[d0],0,0,0);
    o[d0]=__builtin_amdgcn_mfma_f32_32x32x16_bf16(pa2,PK(2),o[d0],0,0,0);
    o[d0]=__builtin_amdgcn_mfma_f32_32x32x16_bf16(pa3,PK(3),o[d0],0,0,0);
    #undef PK
  }
}

#ifndef ATTN_STORE16
#define ATTN_STORE16(p,v) (*(u32x4*)(p)=(v))
#endif
template<int THRL> __device__ __forceinline__ void attn_unit(int b,int qb,const bf16*Q,const bf16*__restrict__ K,const bf16*__restrict__ V,bf16*O,char*shm){
  int tid_=threadIdx.x; asm volatile("":"+v"(tid_)); const int tid=tid_,lane=tid&63,r32=lane&31,hi=lane>>5; const int wid=__builtin_amdgcn_readfirstlane(tid>>6);
  const long rowbase=(long)b*SEQ; const int q0=qb*QB;
  const bf16*Qw=Q+(rowbase+q0+wid*QBLK)*PQ;
  const bf16*Kh=K+rowbase*PQ,*Vh=V+rowbase*PQ;
  const unsigned lds0=(unsigned)(uintptr_t)shm;
  float*wsf=(float*)(shm+LDS_WS)+wid*64;
  const bf16*ksrc=Kh+(long)lane*PQ+wid*8;
  const bf16*vsrc=Vh+(long)(16*(wid&3)+(lane>>2))*PQ+(wid>>2)*32+(lane&3)*8;
  const unsigned kdst=lds0+LDS_K+wid*1024, vdst=lds0+LDS_V+wid*1024;
  #define DMA_K(t,slot) glds16(ksrc+(long)(t)*KVBLK*PQ,(unsigned)__builtin_amdgcn_readfirstlane(kdst+(slot)))
  #define DMA_V(t,slot) glds16(vsrc+(long)(t)*KVBLK*PQ,(unsigned)__builtin_amdgcn_readfirstlane(vdst+(slot)))
  const int vb0=(int)(lds0+LDS_V)+((lane>>4)&1)*32+(lane&3)*8+(4*hi+((lane&15)>>2))*64;
  const char*Kbase=shm+LDS_K; bf16x8 kf[8];
  const lds_cptr shm3=(lds_cptr)shm; const lds_cptr kp0=shm3+LDS_K+hi*1024+r32*16; const lds_cptr vp0=shm3+LDS_V+((lane>>4)&1)*32+(lane&3)*8+(4*hi+((lane&15)>>2))*64;
  int NT=SEQ/KVBLK; asm volatile("":"+s"(NT));
  DMA_K(0,0);DMA_V(0,0);DMA_K(1,SLOTB);
  bf16x8 qr[4];
  #pragma unroll
  for(int d0=0;d0<4;++d0)qr[d0]=*reinterpret_cast<const bf16x8*>(&Qw[(long)r32*PQ+d0*16+hi*8]);
  float mhat=0.f,l_reg=0.f;f32x16 o[2];o[0]=f32x16{};o[1]=f32x16{};f32x16 negm=f32x16{};asm volatile("":"+v"(negm));
    #define CMASK(P0,P1,t) do{}while(0)
  bool resc=false;
  #define START(P0,P1) do{ const float rm=rowmax(P0,P1); resc=false; \
    { const float dl=rm; mhat=fadd_s(mhat,dl); \
      _Pragma("unroll") for(int r=0;r<16;++r){P0[r]=fsub_s(P0[r],dl);P1[r]=fsub_s(P1[r],dl);} \
      _Pragma("unroll") for(int r=0;r<16;++r)negm[r]=-mhat; asm volatile("":"+v"(negm)); } \
    _Pragma("unroll") for(int r=0;r<16;++r)P0[r]=__builtin_amdgcn_exp2f(P0[r]); }while(0)
  #define RESC() do{ if(resc){ asm volatile("s_waitcnt lgkmcnt(0)":::"memory"); \
      _Pragma("unroll") for(int d_=0;d_<2;++d_) _Pragma("unroll") for(int r=0;r<16;++r)o[d_][r]*=wsf[crow(r,hi)]; } }while(0)
  f32x16 pA0,pA1,pB0,pB1;
  int sl_prev=0,sl_cur=0,sl_next=SLOTB;
  #define ROT() do{sl_prev=sl_cur;sl_cur=sl_next;sl_next=(sl_next==(NSLOT-1)*SLOTB)?0:sl_next+SLOTB;}while(0)
  DMA_K(2,2*SLOTB);
  WAIT_BAR(3);
  qkt(pA0,pA1,Kbase,qr,negm,r32,hi);asm volatile("s_nop 15\n\ts_nop 7":"+v"(pA0),"+v"(pA1));CMASK(pA0,pA1,0);
  START(pA0,pA1);
  _Pragma("unroll") for(int r=0;r<16;++r)pA1[r]=__builtin_amdgcn_exp2f(pA1[r]);
  WAIT_BAR(0);
  DMA_K(3,0);DMA_V(1,SLOTB);
  ROT();
  kload8(kf,kp0+sl_cur);
  WAIT_BAR(2);
  s16x4 vlo[8],vhi[8]; u32x4 pw0,pw1,pw2,pw3;
  #define PKW(P,B) cvtpk_s(P[B],P[B+1])
  #define PAF(k) __builtin_bit_cast(bf16x8,pw##k)
  #define VFR(i) (bf16x8){vlo[i][0],vlo[i][1],vlo[i][2],vlo[i][3],vhi[i][0],vhi[i][1],vhi[i][2],vhi[i][3]}
  #define PIN(x) asm volatile("":"+v"(x))
  #define MX3(a,b,c) __builtin_fmaxf(__builtin_fmaxf((a),(b)),(c))
  #define GAPA(MF,A0,A1,A2,A3,W0,W1,PW) do{ MF; sacc+=A0; sacc+=A1; sacc+=A2; sacc+=A3; PIN(sacc); W0; W1; PIN(PW); SBAR(); }while(0)
  #define EX(v) __builtin_amdgcn_exp2f(v)
  #define GAPB(MF,X,B) do{ MF; X[B]=EX(X[B]); X[B+1]=EX(X[B+1]); X[B+2]=EX(X[B+2]); X[B+3]=EX(X[B+3]); PIN(X); SBAR(); }while(0)
  #define VRD(i) do{ vlo[i]=vtr(vp_+(((i)>>2)*4096+((i)&3)*1024)); vhi[i]=vtr(vp_+(((i)>>2)*4096+((i)&3)*1024+512)); }while(0)
  #define KRD(G,j) do{ if(G){ kload2(kf,kp0+sl_next,j); SBAR(); } }while(0)
  #define STEP(C0,C1,P0,P1,t,GK,GV,GL) do{ SBAR(); \
    const lds_cptr vp_=vp0+sl_prev; \
    VRD(0); SBAR(); float sacc=(P0[0]+P0[1]); \
    GAPA(C0=__builtin_amdgcn_mfma_f32_32x32x16_bf16(kf[0],qr[0],negm,0,0,0), P0[2],P0[3],P0[4],P0[5],     pw0[0]=PKW(P0,0), pw0[1]=PKW(P0,2), pw0); \
    VRD(4); SBAR(); GAPA(C1=__builtin_amdgcn_mfma_f32_32x32x16_bf16(kf[1],qr[0],negm,0,0,0), P0[6],P0[7],P0[8],P0[9],     pw0[2]=PKW(P0,4), pw0[3]=PKW(P0,6), pw0); \
    VRD(1); SBAR(); GAPA(C0=__builtin_amdgcn_mfma_f32_32x32x16_bf16(kf[2],qr[1],C0,0,0,0),   P0[10],P0[11],P0[12],P0[13], pw1[0]=PKW(P0,8), pw1[1]=PKW(P0,10), pw1); \
    VRD(5); SBAR(); GAPA(C1=__builtin_amdgcn_mfma_f32_32x32x16_bf16(kf[3],qr[1],C1,0,0,0),   P0[14],P0[15],P1[0],P1[1],   pw1[2]=PKW(P0,12),pw1[3]=PKW(P0,14), pw1); \
    VRD(2); SBAR(); GAPA(C0=__builtin_amdgcn_mfma_f32_32x32x16_bf16(kf[4],qr[2],C0,0,0,0),   P1[2],P1[3],P1[4],P1[5],     pw2[0]=PKW(P1,0), pw2[1]=PKW(P1,2), pw2); \
    VRD(6); SBAR(); GAPA(C1=__builtin_amdgcn_mfma_f32_32x32x16_bf16(kf[5],qr[2],C1,0,0,0),   P1[6],P1[7],P1[8],P1[9],     pw2[2]=PKW(P1,4), pw2[3]=PKW(P1,6), pw2); \
    VRD(3); SBAR(); GAPA(C0=__builtin_amdgcn_mfma_f32_32x32x16_bf16(kf[6],qr[3],C0,0,0,0),   P1[10],P1[11],P1[12],P1[13], pw3[0]=PKW(P1,8), pw3[1]=PKW(P1,10), pw3); \
    VRD(7); SBAR(); GAPA(C1=__builtin_amdgcn_mfma_f32_32x32x16_bf16(kf[7],qr[3],C1,0,0,0),   P1[14],P1[15],0.f,0.f,       pw3[2]=PKW(P1,12),pw3[3]=PKW(P1,14), pw3); \
    l_reg+=sacc; \
    if(GK){DMA_K((t)+3,sl_cur);} if(GV){DMA_V((t)+1,sl_next);} \
    CMASK(C0,C1,t); \
    { float a=MX3(C0[0],C0[1],C1[0]),b=MX3(C0[2],C0[3],C1[1]); a=MX3(a,C1[2],C1[3]); \
      _Pragma("unroll") for(int r=4;r<16;r+=4){a=MX3(a,C0[r],C0[r+1]);b=MX3(b,C0[r+2],C0[r+3]);a=MX3(a,C1[r],C1[r+1]);b=MX3(b,C1[r+2],C1[r+3]);} \
      float rm=__builtin_fmaxf(a,b); { auto rr=__builtin_amdgcn_permlane32_swap(__float_as_uint(rm),__float_as_uint(rm),false,false); rm=__builtin_fmaxf(__uint_as_float(rr[0]),__uint_as_float(rr[1])); } \
      resc=false; \
      if(__builtin_expect(__any(rm>(float)THRL),0)){ const float dl=__builtin_fmaxf(rm,0.f); mhat+=dl; \
        _Pragma("unroll") for(int r=0;r<16;++r){C0[r]-=dl;C1[r]-=dl;} \
        _Pragma("unroll") for(int r=0;r<16;++r)negm[r]=-mhat; asm volatile("":"+v"(negm)); \
        const float f=__builtin_amdgcn_exp2f(-dl); l_reg*=f; if(hi==0)wsf[r32]=f; resc=true; } } \
    SBAR(); \
    GAPB(o[0]=__builtin_amdgcn_mfma_f32_32x32x16_bf16(PAF(0),VFR(0),o[0],0,0,0), C0,0); \
    GAPB(o[1]=__builtin_amdgcn_mfma_f32_32x32x16_bf16(PAF(0),VFR(4),o[1],0,0,0), C0,4); \
    KRD(GL,0); GAPB(o[0]=__builtin_amdgcn_mfma_f32_32x32x16_bf16(PAF(1),VFR(1),o[0],0,0,0), C0,8); \
    KRD(GL,1); GAPB(o[1]=__builtin_amdgcn_mfma_f32_32x32x16_bf16(PAF(1),VFR(5),o[1],0,0,0), C0,12); \
    KRD(GL,2); GAPB(o[0]=__builtin_amdgcn_mfma_f32_32x32x16_bf16(PAF(2),VFR(2),o[0],0,0,0), C1,0); \
    KRD(GL,3); GAPB(o[1]=__builtin_amdgcn_mfma_f32_32x32x16_bf16(PAF(2),VFR(6),o[1],0,0,0), C1,4); \
    GAPB(o[0]=__builtin_amdgcn_mfma_f32_32x32x16_bf16(PAF(3),VFR(3),o[0],0,0,0), C1,8); \
    GAPB(o[1]=__builtin_amdgcn_mfma_f32_32x32x16_bf16(PAF(3),VFR(7),o[1],0,0,0), C1,12); \
    }while(0)
  int t=1;
  #undef CMASK
  #define CMASK(P0,P1,t) do{}while(0)
  for(;t+5<NT;t+=2){
    STEP(pB0,pB1,pA0,pA1,t,true,true,true);     WAIT_BAR(2); RESC(); ROT();
    STEP(pA0,pA1,pB0,pB1,t+1,true,true,true);   WAIT_BAR(2); RESC(); ROT();
  }
  #undef CMASK
  #define CMASK(P0,P1,t) do{}while(0)
  #define ENDW(tt) do{ if((tt)+3<NT){WAIT_BAR(2);} else if((tt)+2<NT){WAIT_BAR(1);} else {WAIT_BAR(0);} }while(0)
  for(;t+1<NT;t+=2){
    STEP(pB0,pB1,pA0,pA1,t,(t+3<NT),(t+1<NT),(t+1<NT));       ENDW(t);   RESC(); ROT();
    STEP(pA0,pA1,pB0,pB1,t+1,(t+4<NT),(t+2<NT),(t+2<NT));     ENDW(t+1); RESC(); ROT();
  }
  STEP(pB0,pB1,pA0,pA1,NT-1,false,false,false); RESC();
  { float sacc=pB0[0]+pB0[1]; _Pragma("unroll") for(int r=2;r<16;++r)sacc+=pB0[r]; _Pragma("unroll") for(int r=0;r<16;++r)sacc+=pB1[r]; l_reg+=sacc;
    pw0=(u32x4){PKW(pB0,0),PKW(pB0,2),PKW(pB0,4),PKW(pB0,6)};pw1=(u32x4){PKW(pB0,8),PKW(pB0,10),PKW(pB0,12),PKW(pB0,14)};pw2=(u32x4){PKW(pB1,0),PKW(pB1,2),PKW(pB1,4),PKW(pB1,6)};pw3=(u32x4){PKW(pB1,8),PKW(pB1,10),PKW(pB1,12),PKW(pB1,14)};
    SBAR(); pv(o,vb0+sl_cur,PAF(0),PAF(1),PAF(2),PAF(3)); }
  #undef PKW
  #undef PAF
  #undef VFR
  #undef PIN
  #undef MX3
  #undef GAPA
  #undef GAPB
  #undef EX
  #undef VRD
  #undef KRD
  #undef STEP
  #undef ENDW
  {auto rr=__builtin_amdgcn_permlane32_swap(__float_as_uint(l_reg),__float_as_uint(l_reg),false,false);l_reg=__uint_as_float(rr[0])+__uint_as_float(rr[1]);}
  if(hi==0)wsf[32+r32]=l_reg;asm volatile("s_waitcnt lgkmcnt(0)":::"memory");
  float rli[16];
  #pragma unroll
  for(int r=0;r<16;++r)rli[r]=__builtin_amdgcn_rcpf(wsf[32+crow(r,hi)]);
  bf16*Ow=O+(rowbase+q0+wid*QBLK)*PO;
  { bf16*stg=(bf16*)(shm+LDS_OST)+wid*2048;
    #pragma unroll
    for(int r=0;r<16;++r){const int orow=crow(r,hi);
      #pragma unroll
      for(int d0=0;d0<2;++d0)stg[orow*64+d0*32+r32]=__float2bfloat16(o[d0][r]*rli[r]);}
    asm volatile("s_waitcnt lgkmcnt(0)":::"memory");
    #pragma unroll
    for(int i=0;i<4;++i){const int row=i*8+(lane>>3),ch=lane&7; const u32x4 v=*(const u32x4*)(stg+row*64+ch*8); ATTN_STORE16(Ow+(long)row*PO+ch*8,v);} }
  asm volatile("s_waitcnt lgkmcnt(0)\n\ts_barrier":::"memory");
  #undef DMA_K
  #undef DMA_V
  #undef CMASK
  #undef START
  #undef RESC
  #undef ROT
}
constexpr int ATTN_LDS_BYTES=LDS_BYTES;
#undef SBAR
#undef WAIT_BAR
}
namespace cg = cooperative_groups;
constexpr int NWAVES = 8;
constexpr int M = 32768, DMODEL = 1024, DFF = 2816, SEQ = 2048, EV_IN = 2304, OD_IN = 1536;
constexpr float EPS = 1e-6f;
constexpr size_t MiB = 1u << 20;
constexpr size_t WS_SSQ = 432 * MiB;
constexpr size_t WS_SGUW = 2 * MiB;
constexpr size_t WS_W1T = 4 * MiB;
constexpr size_t WS_W2T = 92 * MiB;
constexpr size_t WS_EVIN = 136 * MiB;
constexpr size_t WS_EVOUT = 145 * MiB;
constexpr size_t WS_ODIN = 149 * MiB;
constexpr size_t WS_ODOUT = 155 * MiB;
constexpr size_t WS_XB = 160 * MiB;
constexpr size_t WS_ACT = 224 * MiB;
constexpr size_t WS_PROJ = 224 * MiB;
constexpr size_t WS_MIX = 368 * MiB;
constexpr size_t WS_BAR = 440 * MiB, BAR_BYTES = 16384;
constexpr size_t WS_END = 441 * MiB;
constexpr int RING_BYTES = 131072, PTAB_BYTES = 4096, MISC_OFF = RING_BYTES + PTAB_BYTES, LDS_BYTES = 147456;

#define GAS __attribute__((address_space(1)))
#define LAS __attribute__((address_space(3)))
typedef unsigned short bf16;
typedef unsigned v4u __attribute__((ext_vector_type(4)));
typedef unsigned v2u __attribute__((ext_vector_type(2)));
typedef float f32x4 __attribute__((ext_vector_type(4)));
typedef short bf16x8 __attribute__((ext_vector_type(8)));
#define LDS_WAIT() asm volatile("s_waitcnt lgkmcnt(0)" ::: "memory")
__device__ __forceinline__ unsigned f2bf(float f) { unsigned u = __builtin_bit_cast(unsigned, f); return (u + 0x7fffu + ((u >> 16) & 1u)) >> 16; }
__device__ __forceinline__ unsigned pk2(float lo, float hi) { return pg8::cvt_pk_bf16(lo, hi); }
__device__ __forceinline__ float bflo(unsigned u) { return __builtin_bit_cast(float, u << 16); }
__device__ __forceinline__ float bfhi(unsigned u) { return __builtin_bit_cast(float, u & 0xffff0000u); }
#define UNPACK8(X_, W_) do { X_[0] = bflo(W_[0]); X_[1] = bfhi(W_[0]); X_[2] = bflo(W_[1]); X_[3] = bfhi(W_[1]); X_[4] = bflo(W_[2]); X_[5] = bfhi(W_[2]); X_[6] = bflo(W_[3]); X_[7] = bfhi(W_[3]); } while (0)
__device__ __forceinline__ float gelu_tanh(float x) {
    const float z2 = 1.5957691216057308f * (x + 0.044715f * x * x * x);
    return x * __builtin_amdgcn_rcpf(1.0f + __builtin_amdgcn_exp2f(-1.4426950408889634f * z2));
}
__device__ __forceinline__ float wave_sum(float v) {
#pragma unroll
    for (int o = 1; o < 64; o <<= 1) v += __shfl_xor(v, o);
    return v;
}

struct Args { const float* in[21]; float* out; unsigned char* ws; };
#define XB_TMO      128
#define XB_XCNT(j)  (256  + 64 * (j))
#define XB_XSUB(j)  (1280 + 64 * (j))
#define XB_XGEN(j)  (2304 + 64 * (j))
#define XB_TOP      3328
#define XB_TOPGEN   3392
#define XCD_BAR_WORDS 3456
#define XB_SPIN_CAP (1u << 18)

__device__ __forceinline__ unsigned xb_ld(unsigned* p)              { return __hip_atomic_load(p, __ATOMIC_RELAXED, __HIP_MEMORY_SCOPE_AGENT); }
__device__ __forceinline__ unsigned xb_add(unsigned* p, unsigned v) { return __hip_atomic_fetch_add(p, v, __ATOMIC_RELAXED, __HIP_MEMORY_SCOPE_AGENT); }
__device__ __forceinline__ unsigned xb_xcc_id() { return (unsigned)__builtin_amdgcn_s_getreg((3 << 11) | 20) & 0xFu; }
#define XB_SPIN(cond, bar) do { unsigned _sp = 0; while (cond) { __builtin_amdgcn_s_sleep(1); \
    if ((++_sp & 255u) == 0u) { if (xb_ld(&(bar)[XB_TMO])) break; if (_sp > XB_SPIN_CAP) { atomicAdd(&(bar)[XB_TMO], 1u); break; } } } } while (0)

struct XcdBarrier {
    unsigned* bar; unsigned x;
    volatile LAS unsigned* st;
};

__device__ __forceinline__ XcdBarrier xcd_barrier_post(unsigned* bar, volatile LAS unsigned* st) {
    XcdBarrier b; b.bar = bar; b.x = xb_xcc_id(); b.st = st;
    if (threadIdx.x == 0) (void)xb_add(&bar[XB_XCNT(b.x)], 1u);
    return b;
}
__device__ __forceinline__ void xcd_barrier_complete(unsigned* bar, unsigned x, unsigned& nloc, unsigned& nx) {
    const unsigned G = gridDim.x * gridDim.y * gridDim.z;
    unsigned sum, cnt, mine, sp = 0u;
    for (;;) {
        sum = 0u; cnt = 0u; mine = 0u;
#pragma unroll
        for (unsigned j = 0; j < 16; ++j) { const unsigned c = xb_ld(&bar[XB_XCNT(j)]); sum += c; cnt += (c > 0u) ? 1u : 0u; mine = (j == x) ? c : mine; }
        if (sum == G) break;
        __builtin_amdgcn_s_sleep(1);
        if ((++sp & 255u) == 0u) { if (xb_ld(&bar[XB_TMO])) break; if (sp > XB_SPIN_CAP) { atomicAdd(&bar[XB_TMO], 1u); break; } }
    }
    nloc = mine > 0u ? mine : 1u; nx = cnt > 0u ? cnt : 1u;
}

__device__ __forceinline__ void xcd_barrier(const XcdBarrier& b) {
    asm volatile("s_waitcnt vmcnt(0)" ::: "memory");
    __syncthreads();
    if (threadIdx.x == 0) {
        unsigned* bar = b.bar;
        __builtin_amdgcn_s_waitcnt(0);
        unsigned nloc = b.st[0], nx = b.st[1];
        if (nloc == 0u) { xcd_barrier_complete(bar, b.x, nloc, nx); b.st[0] = nloc; b.st[1] = nx; }
        const unsigned old = xb_add(&bar[XB_XSUB(b.x)], 1u);
        const unsigned gen = old / nloc;
        if (old + 1u == (gen + 1u) * nloc) {
            __builtin_amdgcn_fence(__ATOMIC_RELEASE, "agent");
            asm volatile("s_waitcnt vmcnt(0)" ::: "memory");
            const unsigned og = xb_add(&bar[XB_TOP], 1u);
            const unsigned tg = og / nx;
            if (og + 1u == (tg + 1u) * nx) xb_add(&bar[XB_TOPGEN], 1u);
            else XB_SPIN(xb_ld(&bar[XB_TOPGEN]) == tg, bar);
            __builtin_amdgcn_fence(__ATOMIC_ACQUIRE, "agent");
            xb_add(&bar[XB_XGEN(b.x)], 1u);
            asm volatile("s_waitcnt vmcnt(0)" ::: "memory");
        } else {
            XB_SPIN(xb_ld(&bar[XB_XGEN(b.x)]) == gen, bar);
            __builtin_amdgcn_fence(__ATOMIC_ACQUIRE, "agent");
            asm volatile("s_waitcnt vmcnt(0)" ::: "memory");
        }
    }
    __syncthreads();
}


enum { I_X = 0, I_F1N, I_F1WI, I_F1WO, I_MIXN, I_F2N, I_F2WI, I_F2WO, I_EVWI, I_EVCONV, I_EVQN, I_EVKN, I_EVWO, I_ODWI, I_ODPW, I_ODPS, I_ODSN, I_ODSW, I_ODSB, I_ODWO, I_FINN };

__device__ __forceinline__ void tr_item(const float* W, int ldw, const float* gain, bf16* WT, int dstK, int koff, int k0, int n0, int drow, LAS float* scr, int lane) {
#pragma unroll 8
    for (int i = 0; i < 32; ++i) { const int kk = 2 * i + (lane >> 5); float w = W[(size_t)(k0 + kk) * ldw + n0 + (lane & 31)]; if (gain) w *= gain[k0 + kk]; scr[kk * 33 + (lane & 31)] = w; }
    LDS_WAIT(); asm volatile("" ::: "memory");
    const int c = lane & 7;
#pragma unroll
    for (int j = 0; j < 4; ++j) { const int n = (lane >> 3) + 8 * j; const LAS float* s = scr + (8 * c) * 33 + n;
        v4u o; o.x = pk2(s[0 * 33], s[1 * 33]); o.y = pk2(s[2 * 33], s[3 * 33]); o.z = pk2(s[4 * 33], s[5 * 33]); o.w = pk2(s[6 * 33], s[7 * 33]);
        *(GAS v4u*)(WT + (size_t)(drow + n) * dstK + koff + k0 + 8 * c) = o; }
    LDS_WAIT(); asm volatile("" ::: "memory");
}

__device__ __forceinline__ void p0_prologue(const Args& a, LAS unsigned char* lds, int gw, int NGW, int gtid, int GT, int wave, int lane) {
    unsigned char* ws = a.ws;
    LAS float* scr = (LAS float*)(lds + wave * 16384);
    constexpr int N_W1 = 8 * 2816, N_W2 = 8 * 1408, N_EI = 2 * 1152, N_EO = 2 * 512, N_OI = 2 * 768, N_OO = 2 * 256, NITEMS = N_W1 + N_W2 + N_EI + N_EO + N_OI + N_OO;
    for (int it = gw; it < NITEMS; it += NGW) {
        int r = it; const float* W; const float* gain = nullptr; bf16* WT; int ldw, dstK, koff = 0, nblk, mode = 0;
        if (r < N_W1) { const int m = r / 2816; r -= m * 2816; const int l = m & 3, f2 = m >> 2; W = a.in[f2 ? I_F2WI : I_F1WI] + (size_t)l * 1024 * 5632; gain = a.in[f2 ? I_F2N : I_F1N] + l * 1024;
            WT = (bf16*)(ws + WS_W1T) + (size_t)m * 5632 * 1024; ldw = 5632; dstK = 1024; nblk = 176; mode = 1; }
        else if ((r -= N_W1) < N_W2) { const int m = r / 1408; r -= m * 1408; const int l = m & 3, f2 = m >> 2; W = a.in[f2 ? I_F2WO : I_F1WO] + (size_t)l * 2816 * 1024;
            WT = (bf16*)(ws + WS_W2T) + (size_t)m * 1024 * 2816; ldw = 1024; dstK = 2816; nblk = 32; }
        else if ((r -= N_W2) < N_EI) { const int j = r / 1152; r -= j * 1152; W = a.in[I_EVWI] + (size_t)j * 1024 * 2304; gain = a.in[I_MIXN] + (2 * j) * 1024;
            WT = (bf16*)(ws + WS_EVIN) + (size_t)j * 2304 * 1024; ldw = 2304; dstK = 1024; nblk = 72; }
        else if ((r -= N_EI) < N_EO) { const int j = r / 512; r -= j * 512; W = a.in[I_EVWO] + (size_t)j * 1024 * 1024;
            WT = (bf16*)(ws + WS_EVOUT) + (size_t)j * 1024 * 1024; ldw = 1024; dstK = 1024; nblk = 32; }
        else if ((r -= N_EO) < N_OI) { const int j = r / 768; r -= j * 768; W = a.in[I_ODWI] + (size_t)j * 1024 * 1536; gain = a.in[I_MIXN] + (2 * j + 1) * 1024;
            WT = (bf16*)(ws + WS_ODIN) + (size_t)j * 1536 * 1024; ldw = 1536; dstK = 1024; nblk = 48; }
        else { r -= N_OI; const int j = r / 256; r -= j * 256; W = a.in[I_ODWO] + (size_t)j * 1024 * 1024 + (size_t)512 * 1024;
            WT = (bf16*)(ws + WS_ODOUT) + (size_t)j * 1024 * 1024; ldw = 1024; dstK = 1024; koff = 512; nblk = 32; }
        const int kb = r / nblk, nb = r - kb * nblk, k0 = 64 * kb, n0 = 32 * nb;
        int drow = n0;
        if (mode == 1) { const int nn = n0 < 2816 ? n0 : n0 - 2816; drow = (nn >> 7) * 256 + (nn & 127) + (n0 < 2816 ? 0 : 128); }
        tr_item(W, ldw, gain, WT, dstK, koff, k0, n0, drow, scr, lane);
    }
    for (int it = gw; it < 2048; it += NGW) {
        const int j = it >> 10, g = (it >> 8) & 3, cb = (it >> 4) & 15, n = (it & 15) * 64 + lane;
        const float* pw = a.in[I_ODPW] + ((size_t)(j * 4 + g) * 128 + cb * 8) * 128; const float* sc = a.in[I_ODPS] + j * 512 + g * 128; const float* wo = a.in[I_ODWO] + (size_t)j * 1024 * 1024 + (size_t)(g * 128) * 1024 + n;
        float acc[8];
#pragma unroll
        for (int e = 0; e < 8; ++e) acc[e] = 0.f;
        for (int d = 0; d < 128; ++d) { const float wv = wo[(size_t)d * 1024] * sc[d];
#pragma unroll
            for (int e = 0; e < 8; ++e) acc[e] += pw[e * 128 + d] * wv; }
        v4u o; o.x = pk2(acc[0], acc[1]); o.y = pk2(acc[2], acc[3]); o.z = pk2(acc[4], acc[5]); o.w = pk2(acc[6], acc[7]);
        *(v4u*)((bf16*)(ws + WS_ODOUT) + (size_t)j * 1024 * 1024 + (size_t)n * 1024 + g * 128 + cb * 8) = o;
    }
    { const float* x = a.in[I_X]; bf16* xb = (bf16*)(ws + WS_XB); float* ssq0 = (float*)(ws + WS_SSQ);
      for (int m = gw; m < M; m += NGW) { const f32x4* xr = (const f32x4*)(x + (size_t)m * 1024) + lane; f32x4 v[4]; float s = 0.f;
#pragma unroll
          for (int j = 0; j < 4; ++j) { v[j] = xr[64 * j]; s += (v[j].x * v[j].x + v[j].y * v[j].y) + (v[j].z * v[j].z + v[j].w * v[j].w); }
          s = wave_sum(s); if (lane == 0) *(f32x4*)(ssq0 + 4 * (size_t)m) = (f32x4){s, 0.f, 0.f, 0.f};
          v2u* o8 = (v2u*)(xb + (size_t)m * 1024) + lane;
#pragma unroll
          for (int j = 0; j < 4; ++j) { v2u w; w.x = pk2(v[j].x, v[j].y); w.y = pk2(v[j].z, v[j].w); o8[64 * j] = w; } } }
    { const f32x4* s = (const f32x4*)a.in[I_ODSW]; v2u* o = (v2u*)(ws + WS_SGUW); for (int i = gtid; i < 2 * 4 * 128 * 128 / 4; i += GT) { const f32x4 v = s[i]; v2u w; w.x = pk2(v.x, v.y); w.y = pk2(v.z, v.w); o[i] = w; } }
}

__device__ __forceinline__ void even_prep(bf16* proj, bf16* mix, const float* qg, const float* kg, const float* convw, int gtid, int GT) {
    for (int it = gtid; it < M * 80; it += GT) {
        const int tok = it / 80, r = it - tok * 80, h = r >> 3, sub = r & 7;
        bf16* p = proj + (size_t)tok * EV_IN + 1536 + h * 64 + sub * 8;
        const v4u w = *(const v4u*)p; float x[8]; UNPACK8(x, w);
        float s = 0.f;
#pragma unroll
        for (int e = 0; e < 8; ++e) s += x[e] * x[e];
        s += __shfl_xor(s, 1); s += __shfl_xor(s, 2); s += __shfl_xor(s, 4);
        const float rs = __builtin_amdgcn_rsqf(s * (1.0f / 64.0f) + EPS);
        const float* gn = (h < 8 ? qg : kg) + sub * 8;
        const f32x4 g0 = *(const f32x4*)gn, g1 = *(const f32x4*)(gn + 4);
        const float gv[8] = {g0.x, g0.y, g0.z, g0.w, g1.x, g1.y, g1.z, g1.w};
        const int t = tok & (SEQ - 1); const float pos = (float)(sub < 4 ? (t >> 6) : (t & 63));
        const float osc = h < 8 ? attn_body::C2 : 1.0f;
        float o[8];
#pragma unroll
        for (int e = 0; e < 4; ++e) { const int j = (sub & 3) * 4 + e; const float inv = __builtin_amdgcn_exp2f(-(float)j * 0.83048202372184059f);
            const float ang = pos * inv, c = __cosf(ang), sn = __sinf(ang);
            const float x0 = x[2 * e] * rs * gv[2 * e], x1 = x[2 * e + 1] * rs * gv[2 * e + 1];
            o[2 * e] = (x0 * c - x1 * sn) * osc; o[2 * e + 1] = (x0 * sn + x1 * c) * osc; }
        v4u ow; ow.x = pk2(o[0], o[1]); ow.y = pk2(o[2], o[3]); ow.z = pk2(o[4], o[5]); ow.w = pk2(o[6], o[7]);
        *(v4u*)p = ow;
    }
    for (int it = gtid; it < M * 64; it += GT) {
        const int tok = it >> 6, c = (it & 63) * 8, t = tok & (SEQ - 1);
        const bf16* pr = proj + (size_t)tok * EV_IN + c;
        const v4u zero = (v4u){0u, 0u, 0u, 0u};
        const v4u wb = *(const v4u*)pr, wc1 = *(const v4u*)(pr + 512), wh1 = *(const v4u*)(pr + 1024);
        const v4u wc0 = t > 0 ? *(const v4u*)(pr - EV_IN + 512) : zero, wh0 = t > 0 ? *(const v4u*)(pr - EV_IN + 1024) : zero;
        const v4u wc2 = t < SEQ - 1 ? *(const v4u*)(pr + EV_IN + 512) : zero, wh2 = t < SEQ - 1 ? *(const v4u*)(pr + EV_IN + 1024) : zero;
        float gb[8], c0[8], h0[8], c1[8], h1[8], c2[8], h2[8];
        UNPACK8(gb, wb); UNPACK8(c0, wc0); UNPACK8(h0, wh0); UNPACK8(c1, wc1); UNPACK8(h1, wh1); UNPACK8(c2, wc2); UNPACK8(h2, wh2);
        const f32x4 a0 = *(const f32x4*)(convw + c), a1 = *(const f32x4*)(convw + c + 4), b0 = *(const f32x4*)(convw + 512 + c), b1 = *(const f32x4*)(convw + 512 + c + 4), d0 = *(const f32x4*)(convw + 1024 + c), d1 = *(const f32x4*)(convw + 1024 + c + 4);
        const float w0[8] = {a0.x, a0.y, a0.z, a0.w, a1.x, a1.y, a1.z, a1.w}, w1[8] = {b0.x, b0.y, b0.z, b0.w, b1.x, b1.y, b1.z, b1.w}, w2[8] = {d0.x, d0.y, d0.z, d0.w, d1.x, d1.y, d1.z, d1.w};
        float o[8];
#pragma unroll
        for (int e = 0; e < 8; ++e) o[e] = gb[e] * (w0[e] * (c0[e] * h0[e]) + w1[e] * (c1[e] * h1[e]) + w2[e] * (c2[e] * h2[e]));
        v4u ow; ow.x = pk2(o[0], o[1]); ow.y = pk2(o[2], o[3]); ow.z = pk2(o[4], o[5]); ow.w = pk2(o[6], o[7]);
        *(v4u*)(mix + (size_t)tok * 1024 + c) = ow;
    }
}

__device__ __forceinline__ void odd_pool(const bf16* proj, bf16* mix, int gtid, int GT) {
    for (int it = gtid; it < M * 64; it += GT) {
        const int tok = it >> 6, c = (it & 63) * 8, t = tok & (SEQ - 1), r = 1 << (c >> 7);
        const int lo = t - r < 0 ? 0 : t - r, hi = t + r > SEQ - 1 ? SEQ - 1 : t + r;
        const bf16* pb = proj + (size_t)(tok - t) * OD_IN + c;
        float acc[8];
#pragma unroll
        for (int e = 0; e < 8; ++e) acc[e] = 0.f;
        for (int tt = lo; tt <= hi; ++tt) { const v4u w = *(const v4u*)(pb + (size_t)tt * OD_IN); float x[8]; UNPACK8(x, w);
#pragma unroll
            for (int e = 0; e < 8; ++e) acc[e] += x[e]; }
        const float inv = 1.0f / (float)(hi - lo + 1);
        const v4u ws_ = *(const v4u*)(pb + (size_t)t * OD_IN); float xs[8]; UNPACK8(xs, ws_);
        v4u ow; ow.x = pk2(acc[0] * inv - xs[0], acc[1] * inv - xs[1]); ow.y = pk2(acc[2] * inv - xs[2], acc[3] * inv - xs[3]);
        ow.z = pk2(acc[4] * inv - xs[4], acc[5] * inv - xs[5]); ow.w = pk2(acc[6] * inv - xs[6], acc[7] * inv - xs[7]);
        *(v4u*)(mix + (size_t)tok * 1024 + c) = ow;
    }
}

__device__ __forceinline__ void sgu_chunk(int ch, const bf16* proj, const bf16* sguw, const float* norm_g, const float* b_s, bf16* mix, LAS unsigned char* lds, int tid, int lane, int wave) {
    LAS float* rstd = (LAS float*)lds;
    LAS unsigned short* vnT = (LAS unsigned short*)(lds + 512);
    const size_t row0 = (size_t)ch * 128;
    const int q = tid >> 2, part = tid & 3, fr = lane & 15, fq = lane >> 4;
    { const bf16* vp = proj + (row0 + q) * OD_IN + 1024 + part * 128; float s = 0.f;
#pragma unroll 4
      for (int i = 0; i < 16; ++i) { const v4u w = *(const v4u*)(vp + 8 * i); float x[8]; UNPACK8(x, w);
#pragma unroll
          for (int e = 0; e < 8; ++e) { const float gl = gelu_tanh(x[e]); s += gl * gl; } }
      s += __shfl_xor(s, 1); s += __shfl_xor(s, 2);
      if (part == 0) rstd[q] = __builtin_amdgcn_rsqf(s * (1.0f / 512.0f) + EPS); }
    __syncthreads();
    for (int g = 0; g < 4; ++g) {
        { const float rs = rstd[q]; const int cs = part * 32; const bf16* vp = proj + (row0 + q) * OD_IN + 1024 + g * 128 + cs; const float* ng = norm_g + g * 128 + cs;
#pragma unroll
          for (int i = 0; i < 4; ++i) { const v4u w = *(const v4u*)(vp + 8 * i); float x[8]; UNPACK8(x, w);
              const f32x4 n0 = *(const f32x4*)(ng + 8 * i), n1 = *(const f32x4*)(ng + 8 * i + 4); const float nv[8] = {n0.x, n0.y, n0.z, n0.w, n1.x, n1.y, n1.z, n1.w};
#pragma unroll
              for (int e = 0; e < 8; ++e) vnT[(cs + 8 * i + e) * 136 + q] = (unsigned short)f2bf(gelu_tanh(x[e]) * rs * nv[e]); } }
        __syncthreads();
        f32x4 acc[8];
#pragma unroll
        for (int n = 0; n < 8; ++n) acc[n] = (f32x4){0.f, 0.f, 0.f, 0.f};
        const int p = 16 * wave + fr;
#pragma unroll
        for (int ks = 0; ks < 4; ++ks) { const bf16x8 af = *(const bf16x8*)(sguw + ((size_t)(g * 128 + p) * 128 + 32 * ks + 8 * fq));
#pragma unroll
            for (int n = 0; n < 8; ++n) { const bf16x8 bfv = *(const LAS bf16x8*)(vnT + (16 * n + fr) * 136 + 32 * ks + 8 * fq);
                acc[n] = __builtin_amdgcn_mfma_f32_16x16x32_bf16(bfv, af, acc[n], 0, 0, 0); } }
        const float bias = b_s[g * 128 + p];
        const bf16* up = proj + (row0 + p) * OD_IN + 512 + g * 128 + 4 * fq; bf16* op = mix + (row0 + p) * 1024 + 512 + g * 128 + 4 * fq;
#pragma unroll
        for (int n = 0; n < 8; ++n) { const v2u uw = *(const v2u*)(up + 16 * n);
            v2u ow; ow.x = pk2(gelu_tanh(bflo(uw.x)) * (acc[n][0] + bias), gelu_tanh(bfhi(uw.x)) * (acc[n][1] + bias)); ow.y = pk2(gelu_tanh(bflo(uw.y)) * (acc[n][2] + bias), gelu_tanh(bfhi(uw.y)) * (acc[n][3] + bias));
            *(v2u*)(op + 16 * n) = ow; }
        __syncthreads();
    }
}

struct Ctx { int tid, lane, wave, G, bx, vcu, gw, NGW, gtid, GT; };
__device__ __forceinline__ Ctx mkctx() {
    Ctx c; int t = threadIdx.x; asm volatile("" : "+v"(t)); int g = gridDim.x, b = blockIdx.x; asm volatile("" : "+s"(g), "+s"(b));
    c.tid = t; c.lane = t & 63; c.wave = __builtin_amdgcn_readfirstlane(t >> 6); c.G = g; c.bx = b;
    c.vcu = (g % 8 == 0) ? (b % 8) * (g / 8) + b / 8 : b;
    c.gw = c.vcu * NWAVES + c.wave; c.NGW = g * NWAVES; c.gtid = b * (NWAVES * 64) + t; c.GT = g * NWAVES * 64; return c;
}
__device__ __forceinline__ const Args* kargs() { auto p = __builtin_amdgcn_kernarg_segment_ptr(); asm volatile("" : "+s"(p)); return (const Args*)p; }
#define CG_SYNC() do { asm volatile("s_waitcnt vmcnt(0) lgkmcnt(0)" ::: "memory"); __syncthreads(); cg::this_grid().sync(); __builtin_amdgcn_fence(__ATOMIC_ACQUIRE, "agent"); asm volatile("s_waitcnt vmcnt(0)" ::: "memory"); } while (0)
#define GRID_SYNC() do { XcdBarrier b_; b_.bar = (unsigned*)(kargs()->ws + WS_BAR); b_.x = xb_xcc_id(); b_.st = (volatile LAS unsigned*)(lds + MISC_OFF); xcd_barrier(b_); } while (0)

__global__ void __launch_bounds__(NWAVES * 64, 2) mega_fwd(Args args_unused) {
    extern __shared__ __attribute__((aligned(16))) unsigned char lds_raw[];
    LAS unsigned char* lds = (LAS unsigned char*)lds_raw;
    if (threadIdx.x == 0) { ((volatile LAS unsigned*)(lds + MISC_OFF))[0] = 0u; ((volatile LAS unsigned*)(lds + MISC_OFF))[1] = 0u; }
    __syncthreads();
    (void)xcd_barrier_post((unsigned*)(kargs()->ws + WS_BAR), (volatile LAS unsigned*)(lds + MISC_OFF));
#ifndef DUP_P0
#define DUP_P0 0
#endif
    for (int rp = 0; rp <= DUP_P0; ++rp) { const Ctx c = mkctx(); const Args* A = kargs(); p0_prologue(*A, lds, c.gw, c.NGW, c.gtid, c.GT, c.wave, c.lane); }
    CG_SYNC();

    for (int j = 0; j < 12; ++j) {
        const int l = j / 3, kind = j - 3 * l;
        if (kind != 1) {
            const int wi = (kind == 2 ? 4 : 0) + l;
#ifndef DUP_G1
#define DUP_G1 0
#endif
            for (int rp = 0; rp <= DUP_G1; ++rp) { const Ctx c = mkctx(); const Args* A = kargs(); unsigned char* ws = A->ws;
              pg8::Gemm g{(const bf16*)(ws + WS_XB), (const bf16*)(ws + WS_W1T) + (size_t)wi * 5632 * 1024, M, 2 * DFF, DMODEL}; pg8::StaticOrder S; S.init(M, 2 * DFF, c.G, c.bx);
              pg8::EpiSwiGLU E{(bf16*)(ws + WS_ACT), DFF, (const float*)(ws + WS_SSQ) + (size_t)j * M * 4};
              pg8::gemm_phase<pg8::EpiSwiGLU, pg8::StaticOrder, true, true>(lds, g, S, E); }
            GRID_SYNC();
        } else {
            const int jj = l >> 1; const bool even = (l & 1) == 0;
#ifndef DUP_G3
#define DUP_G3 0
#endif
            for (int rp = 0; rp <= DUP_G3; ++rp) { const Ctx c = mkctx(); const Args* A = kargs(); unsigned char* ws = A->ws; const int N = even ? EV_IN : OD_IN;
              const bf16* wt = even ? (const bf16*)(ws + WS_EVIN) + (size_t)jj * EV_IN * 1024 : (const bf16*)(ws + WS_ODIN) + (size_t)jj * OD_IN * 1024;
              pg8::Gemm g{(const bf16*)(ws + WS_XB), wt, M, N, DMODEL}; pg8::StaticOrder S; S.init(M, N, c.G, c.bx);
              pg8::EpiRowScale E{(bf16*)(ws + WS_PROJ), N, (const float*)(ws + WS_SSQ) + (size_t)j * M * 4};
              pg8::gemm_phase<pg8::EpiRowScale, pg8::StaticOrder, true, true>(lds, g, S, E); }
            GRID_SYNC();
            if (even) {
                { const Ctx c = mkctx(); const Args* A = kargs(); unsigned char* ws = A->ws;
                  even_prep((bf16*)(ws + WS_PROJ), (bf16*)(ws + WS_MIX), A->in[I_EVQN] + jj * 64, A->in[I_EVKN] + jj * 64, A->in[I_EVCONV] + jj * 3 * 512, c.gtid, c.GT); }
                GRID_SYNC();
#ifndef DUP_ATTN
#define DUP_ATTN 0
#endif
                for (int rp = 0; rp <= DUP_ATTN; ++rp) { const Ctx c = mkctx(); const Args* A = kargs(); unsigned char* ws = A->ws; const attn_body::bf16* PROJ = (const attn_body::bf16*)(ws + WS_PROJ); attn_body::bf16* MIX = (attn_body::bf16*)(ws + WS_MIX);
                  for (int ui = c.vcu; ui < 1024; ui += c.G) {
                      const int bh = ui >> 3, qb = ui & 7, b = bh >> 3, h = bh & 7, kvh = h >> 2;
                      attn_body::attn_unit<8>(b, qb, PROJ + 1536 + h * 64, PROJ + 2048 + kvh * 64, PROJ + 2176 + kvh * 64, MIX + 512 + h * 64, (char*)lds_raw);
                  } }
            } else {
                { const Ctx c = mkctx(); const Args* A = kargs(); unsigned char* ws = A->ws; odd_pool((const bf16*)(ws + WS_PROJ), (bf16*)(ws + WS_MIX), c.gtid, c.GT); }
#ifndef DUP_SGU
#define DUP_SGU 0
#endif
                for (int rp = 0; rp <= DUP_SGU; ++rp)
                { const Ctx c = mkctx(); const Args* A = kargs(); unsigned char* ws = A->ws;
                  for (int ch = c.vcu; ch < 256; ch += c.G)
                      sgu_chunk(ch, (const bf16*)(ws + WS_PROJ), (const bf16*)(ws + WS_SGUW) + (size_t)jj * 4 * 128 * 128, A->in[I_ODSN] + jj * 512, A->in[I_ODSB] + jj * 512, (bf16*)(ws + WS_MIX), lds, c.tid, c.lane, c.wave); }
            }
            GRID_SYNC();
        }
#ifndef DUP_G2
#define DUP_G2 0
#endif
        for (int rp = 0; rp <= DUP_G2; ++rp) { const Ctx c = mkctx(); const Args* A = kargs(); unsigned char* ws = A->ws; float* out = A->out; const bool ffn = kind != 1; const int jj = l >> 1;
          const bf16* wt = ffn ? (const bf16*)(ws + WS_W2T) + (size_t)((kind == 2 ? 4 : 0) + l) * 1024 * 2816 : ((l & 1) == 0 ? (const bf16*)(ws + WS_EVOUT) : (const bf16*)(ws + WS_ODOUT)) + (size_t)jj * 1024 * 1024;
          pg8::Gemm g{ffn ? (const bf16*)(ws + WS_ACT) : (const bf16*)(ws + WS_MIX), wt, M, DMODEL, ffn ? DFF : DMODEL}; pg8::StaticOrder S; S.init(M, DMODEL, c.G, c.bx);
          pg8::EpiResid E{(j == 0) ? A->in[I_X] : out, out, (bf16*)(ws + WS_XB), (float*)(ws + WS_SSQ) + (size_t)(j + 1) * M * 4, rp < DUP_G2 ? 0.0f : (ffn ? 0.5f : 1.0f)};
          pg8::gemm_phase<pg8::EpiResid, pg8::StaticOrder, true, true>(lds, g, S, E); }
        GRID_SYNC();
#ifdef DUP_SYNC
        GRID_SYNC(); GRID_SYNC();
#endif
    }
    { const Ctx c = mkctx(); const Args* A = kargs(); float* out = A->out; const float* ssq = (const float*)(A->ws + WS_SSQ) + (size_t)12 * M * 4; const f32x4* gf = (const f32x4*)A->in[I_FINN];
      for (int m = c.gw; m < M; m += c.NGW) { const float rs = pg8::row_rs(ssq, m); f32x4* xr = (f32x4*)(out + (size_t)m * 1024) + c.lane;
#pragma unroll
          for (int q = 0; q < 4; ++q) xr[64 * q] = xr[64 * q] * rs * gf[c.lane + 64 * q]; } }
}

extern "C" void kernel_launch(void* const* d_in, const int* in_sizes, int n_in, void* d_out, int out_size, void* d_ws, size_t ws_size, hipStream_t stream) {
    static int grid = 0;
    if (grid == 0) {
        if (n_in != 21 || in_sizes[0] != M * DMODEL || out_size != M * DMODEL || ws_size < WS_END) { fprintf(stderr, "kernel_launch: unexpected shapes (n_in %d, in0 %d, out %d, ws %zu)\n", n_in, n_in > 0 ? in_sizes[0] : -1, out_size, ws_size); grid = -1; return; }
        int dev = 0, cus = 0, per_cu = 0;
        if (hipGetDevice(&dev) != hipSuccess || hipDeviceGetAttribute(&cus, hipDeviceAttributeMultiprocessorCount, dev) != hipSuccess) { grid = -1; return; }
        if (hipFuncSetAttribute((const void*)mega_fwd, hipFuncAttributeMaxDynamicSharedMemorySize, LDS_BYTES) != hipSuccess) { fprintf(stderr, "kernel_launch: hipFuncSetAttribute failed\n"); grid = -1; return; }
        if (hipOccupancyMaxActiveBlocksPerMultiprocessor(&per_cu, (const void*)mega_fwd, NWAVES * 64, LDS_BYTES) != hipSuccess || per_cu < 1) { fprintf(stderr, "kernel_launch: occupancy query says %d\n", per_cu); per_cu = 1; }
        (void)hipGetLastError();
        grid = cus * per_cu;
    }
    if (grid < 0) return;
    if (hipMemsetAsync((char*)d_ws + WS_BAR, 0, BAR_BYTES, stream) != hipSuccess) { fprintf(stderr, "kernel_launch: hipMemsetAsync failed\n"); return; }
    Args a{};
    for (int i = 0; i < 21; ++i) a.in[i] = (const float*)d_in[i];
    a.out = (float*)d_out; a.ws = (unsigned char*)d_ws;
    void* params[] = {&a};
    hipError_t e = hipLaunchCooperativeKernel((const void*)mega_fwd, dim3(grid), dim3(NWAVES * 64), params, LDS_BYTES, stream);
    if (e != hipSuccess) fprintf(stderr, "kernel_launch: cooperative launch failed: %s (grid %d)\n", hipGetErrorString(e), grid);
}
```

```cpp
#include <hip/hip_runtime.h>
#include <hip/hip_cooperative_groups.h>
#include <hip/hip_bf16.h>
#include <cstdio>
#include <cstdint>
#include <cmath>
namespace pg8 {
#define PG8_LAS __attribute__((address_space(3)))
typedef unsigned short bf16_t;
typedef short bf16x8 __attribute__((ext_vector_type(8)));
typedef float f32x4 __attribute__((ext_vector_type(4)));
typedef unsigned u32x4 __attribute__((ext_vector_type(4)));
constexpr int BM = 256, BK = 64, HALF = 128, HTB = HALF * BK * 2  , STAGE_BYTES = 8 * HTB, NXCD = 8, WGM = 8;

__host__ __device__ __forceinline__ int lds_byte(int r, int c) { const int st = (r >> 4) * 2 + (c >> 5), rr = r & 15, cc = c & 31, ob = rr * 64 + cc * 2; return st * 1024 + (ob ^ (((ob >> 9) & 1) << 5)); }
__host__ __device__ __forceinline__ void stage_rc(int b, int& R, int& C) { const int st = b / 1024, sb = b % 1024, swz = sb ^ (((sb >> 9) & 1) << 5); R = (st >> 1) * 16 + swz / 64; C = (st & 1) * 32 + (swz % 64) / 2; }
__host__ __device__ __forceinline__ int perm32(int rho) { const int n = rho >> 4, i = rho & 15; return 8 * (i >> 2) + 4 * n + (i & 3); }

struct Unit { int pm, pn; };
struct Gemm { const bf16_t* A; const bf16_t* Bt; int M, N, K; };

struct StaticOrder {
    int nM, nN, nwg, G, c;
    __host__ __device__ void init(int M, int N, int G_, int c_) { nM = M / BM; nN = N / BM; nwg = nM * nN; G = G_; c = c_; }
    __host__ __device__ bool next(int i, Unit& u) const {
        const long L = (long)i * G + c; if (L >= nwg) return false;
        int wgid = (int)L; { const int q = nwg / NXCD, r = nwg % NXCD, xcd = wgid % NXCD, off = wgid / NXCD; wgid = (xcd < r ? xcd * (q + 1) : r * (q + 1) + (xcd - r) * q) + off; }
        const int nig = WGM * nN, gid = wgid / nig, fm = gid * WGM, gsz = (nM - fm) < WGM ? (nM - fm) : WGM;
        u.pm = fm + ((wgid % nig) % gsz); u.pn = (wgid % nig) / gsz; return true;
    }
    __device__ __forceinline__ void a_ready(const Unit&) const {}
    __device__ __forceinline__ void done(const Unit&) const {}
};
__device__ __forceinline__ unsigned cvt_pk_bf16(float lo, float hi) { unsigned r; asm volatile("v_cvt_pk_bf16_f32 %0, %1, %2" : "=v"(r) : "v"(lo), "v"(hi)); return r; }
typedef float f32x2 __attribute__((ext_vector_type(2)));
__device__ __forceinline__ float row_rs(const float* ssq, int row) { const f32x4 p = *(const f32x4*)(ssq + 4 * (size_t)row); return __builtin_amdgcn_rsqf(((p[0] + p[1]) + (p[2] + p[3])) * (1.0f / 1024.0f) + 1e-6f); }
__device__ __forceinline__ float silu_f(float g) { return g * __builtin_amdgcn_rcpf(1.0f + __builtin_amdgcn_exp2f(-1.4426950408889634f * g)); }
struct EpiSwiGLU {
    static constexpr bool PERM = true, AFTER_DRAIN = false;
    bf16_t* O; int ldc; const float* ssq;
    __device__ __forceinline__ void operator()(const f32x4 (&acc)[2][2][4][2], const Unit& u, int wr, int wc, int fr, int fq) const {
        const int row0 = u.pm * BM + wr * 64 + fr, col0 = u.pn * HALF + wc * 32 + 8 * fq;
#pragma unroll
        for (int ai = 0; ai < 2; ++ai)
#pragma unroll
            for (int m = 0; m < 4; ++m) { const int row = row0 + ai * HALF + m * 16; const float rs = row_rs(ssq, row);
                const f32x4 g0 = acc[ai][0][m][0] * rs, g1 = acc[ai][0][m][1] * rs, u0 = acc[ai][1][m][0] * rs, u1 = acc[ai][1][m][1] * rs;
                u32x4 w; w.x = cvt_pk_bf16(silu_f(g0[0]) * u0[0], silu_f(g0[1]) * u0[1]); w.y = cvt_pk_bf16(silu_f(g0[2]) * u0[2], silu_f(g0[3]) * u0[3]);
                w.z = cvt_pk_bf16(silu_f(g1[0]) * u1[0], silu_f(g1[1]) * u1[1]); w.w = cvt_pk_bf16(silu_f(g1[2]) * u1[2], silu_f(g1[3]) * u1[3]);
                *(u32x4*)(O + (size_t)row * ldc + col0) = w; }
    }
};
struct EpiRowScale {
    static constexpr bool PERM = true, AFTER_DRAIN = false;
    bf16_t* O; int ldc; const float* ssq;
    __device__ __forceinline__ void operator()(const f32x4 (&acc)[2][2][4][2], const Unit& u, int wr, int wc, int fr, int fq) const {
        const int row0 = u.pm * BM + wr * 64 + fr, col0 = u.pn * BM + wc * 32 + 8 * fq;
#pragma unroll
        for (int ai = 0; ai < 2; ++ai)
#pragma unroll
            for (int m = 0; m < 4; ++m) { const int row = row0 + ai * HALF + m * 16; const float rs = row_rs(ssq, row); bf16_t* rowp = O + (size_t)row * ldc + col0;
#pragma unroll
                for (int bj = 0; bj < 2; ++bj) { const f32x4 v0 = acc[ai][bj][m][0] * rs, v1 = acc[ai][bj][m][1] * rs;
                    u32x4 w; w.x = cvt_pk_bf16(v0[0], v0[1]); w.y = cvt_pk_bf16(v0[2], v0[3]); w.z = cvt_pk_bf16(v1[0], v1[1]); w.w = cvt_pk_bf16(v1[2], v1[3]);
                    *(u32x4*)(rowp + bj * HALF) = w; } }
    }
};
struct EpiResid {
    static constexpr bool PERM = true, AFTER_DRAIN = false;
    bf16_t* xb; float* ssq_out; float alpha;
    __device__ __forceinline__ void operator()(const f32x4 (&acc)[2][2][4][2], const Unit& u, int wr, int wc, int fr, int fq) const {
        PG8_LAS float* P = (PG8_LAS float*)(STAGE_BYTES);
        const int row0 = u.pm * BM + wr * 64 + fr, col0 = u.pn * BM + wc * 32 + 8 * fq;
#pragma unroll
        for (int ai = 0; ai < 2; ++ai)
#pragma unroll
            for (int m = 0; m < 4; ++m) { const int row = row0 + ai * HALF + m * 16; bf16_t* rowp = xb + (size_t)row * 1024 + col0; float s = 0.f;
#pragma unroll
                for (int bj = 0; bj < 2; ++bj) { const u32x4 b = *(const u32x4*)(rowp + bj * HALF);
                    const f32x4 b0 = {__builtin_bit_cast(float, b.x << 16), __builtin_bit_cast(float, b.x & 0xffff0000u), __builtin_bit_cast(float, b.y << 16), __builtin_bit_cast(float, b.y & 0xffff0000u)};
                    const f32x4 b1 = {__builtin_bit_cast(float, b.z << 16), __builtin_bit_cast(float, b.z & 0xffff0000u), __builtin_bit_cast(float, b.w << 16), __builtin_bit_cast(float, b.w & 0xffff0000u)};
                    const f32x4 o0 = b0 + acc[ai][bj][m][0] * alpha, o1 = b1 + acc[ai][bj][m][1] * alpha;
                    s += ((o0[0] * o0[0] + o0[1] * o0[1]) + (o0[2] * o0[2] + o0[3] * o0[3])) + ((o1[0] * o1[0] + o1[1] * o1[1]) + (o1[2] * o1[2] + o1[3] * o1[3]));
                    u32x4 w; w.x = cvt_pk_bf16(o0[0], o0[1]); w.y = cvt_pk_bf16(o0[2], o0[3]); w.z = cvt_pk_bf16(o1[0], o1[1]); w.w = cvt_pk_bf16(o1[2], o1[3]);
                    *(u32x4*)(rowp + bj * HALF) = w; }
                s += __shfl_xor(s, 16); s += __shfl_xor(s, 32);
                if (fq == 0) P[(ai * HALF + wr * 64 + m * 16 + fr) * 4 + wc] = s;
                if (m & 1) asm volatile("" ::: "memory"); }
        asm volatile("s_waitcnt lgkmcnt(0)" ::: "memory"); __builtin_amdgcn_s_barrier(); asm volatile("" ::: "memory");
        int t = threadIdx.x; asm volatile("" : "+v"(t));
        if (t < 256) { const f32x4 p = *(const PG8_LAS f32x4*)(P + 4 * t); ssq_out[(size_t)(u.pm * BM + t) * 4 + u.pn] = (p[0] + p[1]) + (p[2] + p[3]); }
    }
};

template <class Epi, class Sched, bool ALIGN_EPI = false, bool SP2 = false>
__device__ __forceinline__ void gemm_phase(PG8_LAS unsigned char* lds, const Gemm g, const Sched& S, const Epi& E) {
    int tid_ = threadIdx.x; asm volatile("" : "+v"(tid_));
    const int tid = tid_, wid = __builtin_amdgcn_readfirstlane(tid >> 6), lane = tid & 63, wr = wid >> 2, wc = wid & 3, fr = lane & 15, fq = lane >> 4;
    const int K = g.K, nt = K / BK;
    unsigned voffA[2], voffB[2];
#pragma unroll
    for (int i = 0; i < 2; ++i) { int R, C; stage_rc(tid * 16 + i * 8192, R, C); const int Rb = Epi::PERM ? ((R & ~31) + perm32(R & 31)) : R;
        voffA[i] = (unsigned)(R * K + C) * 2u; voffB[i] = (unsigned)(Rb * K + C) * 2u; }
    const size_t kstep = (size_t)(BK * 2);
    const size_t hstep = (size_t)HALF * K * 2;
    const size_t tstep = 2 * hstep;
    const unsigned ldsw = (unsigned)wid * 1024u;
    const int aoff = lds_byte(wr * 64 + fr, fq * 8), boff = lds_byte(wc * 32 + fr, fq * 8);
#define PG8_SA(b, h) (((b) * 2 + (h)) * HTB)
#define PG8_SB(b, h) ((4 + (b) * 2 + (h)) * HTB)
#define PG8_STAGE(bufoff, gbase, voff) do { _Pragma("unroll") for (int _i = 0; _i < 2; ++_i) \
        __builtin_amdgcn_global_load_lds((const unsigned*)((const char*)(gbase) + (voff)[_i]), (PG8_LAS unsigned*)(lds + (bufoff) + ldsw + _i * 8192), 16, 0, 0); } while (0)
#define PG8_LDA(dst, b, h) do { _Pragma("unroll") for (int m = 0; m < 4; ++m) _Pragma("unroll") for (int k = 0; k < 2; ++k) dst[m][k] = *(const PG8_LAS bf16x8*)(lds + PG8_SA(b, h) + aoff + m * 2048 + k * 1024); } while (0)
#define PG8_LDB(dst, b, h) do { _Pragma("unroll") for (int n = 0; n < 2; ++n) _Pragma("unroll") for (int k = 0; k < 2; ++k) dst[n][k] = *(const PG8_LAS bf16x8*)(lds + PG8_SB(b, h) + boff + n * 2048 + k * 1024); } while (0)
#define PG8_MMA(ai, bj, At, Bt) do { __builtin_amdgcn_s_setprio(1); _Pragma("unroll") for (int m = 0; m < 4; ++m) _Pragma("unroll") for (int n = 0; n < 2; ++n) _Pragma("unroll") for (int k = 0; k < 2; ++k) \
        acc[ai][bj][m][n] = __builtin_amdgcn_mfma_f32_16x16x32_bf16(Bt[n][k], At[m][k], acc[ai][bj][m][n], 0, 0, 0); __builtin_amdgcn_s_setprio(0); } while (0)
#define PG8_WAIT_V(n) asm volatile("s_waitcnt vmcnt(" #n ")" ::: "memory")
#define PG8_WAIT_L(n) asm volatile("s_waitcnt lgkmcnt(" #n ")" ::: "memory")
#define PG8_BAR __builtin_amdgcn_s_barrier()
#define PG8_SCHED __builtin_amdgcn_sched_barrier(0)
    Unit cur, nxt; int ui = 0;
    if (!S.next(0, cur)) return;
    f32x4 acc[2][2][4][2];
#pragma unroll
    for (int a = 0; a < 2; ++a)
#pragma unroll
        for (int b = 0; b < 2; ++b)
#pragma unroll
            for (int m = 0; m < 4; ++m)
#pragma unroll
                for (int n = 0; n < 2; ++n) acc[a][b][m][n] = (f32x4){0.f, 0.f, 0.f, 0.f};
    bf16x8 At[4][2], B0[2][2], B1[2][2];
    const char* cA = (const char*)g.A + (size_t)cur.pm * tstep; const char* cB = (const char*)g.Bt + (size_t)cur.pn * tstep;
    S.a_ready(cur);
    if constexpr (SP2) {
        PG8_STAGE(PG8_SB(0, 0), cB, voffB); PG8_STAGE(PG8_SB(0, 1), cB + hstep, voffB); PG8_STAGE(PG8_SA(0, 0), cA, voffA); PG8_STAGE(PG8_SA(0, 1), cA + hstep, voffA);
        if (wr == 1) PG8_BAR;
        PG8_WAIT_V(2); PG8_BAR;
        PG8_STAGE(PG8_SB(1, 0), cB + kstep, voffB); PG8_STAGE(PG8_SA(1, 0), cA + kstep, voffA); PG8_STAGE(PG8_SB(1, 1), cB + hstep + kstep, voffB);
        PG8_WAIT_V(6); PG8_BAR;
    } else {
        PG8_STAGE(PG8_SB(0, 0), cB, voffB); PG8_STAGE(PG8_SA(0, 0), cA, voffA); PG8_STAGE(PG8_SB(0, 1), cB + hstep, voffB); PG8_STAGE(PG8_SA(0, 1), cA + hstep, voffA);
        if (wr == 1) PG8_BAR;
        PG8_WAIT_V(4); PG8_BAR;
        PG8_STAGE(PG8_SB(1, 0), cB + kstep, voffB); PG8_STAGE(PG8_SA(1, 0), cA + kstep, voffA); PG8_STAGE(PG8_SB(1, 1), cB + hstep + kstep, voffB);
        PG8_WAIT_V(6); PG8_BAR;
    }
    for (;;) {
        const bool has_next = S.next(ui + 1, nxt);
        const char* nA = has_next ? (const char*)g.A + (size_t)nxt.pm * tstep : cA; const char* nB = has_next ? (const char*)g.Bt + (size_t)nxt.pn * tstep : cB;
        for (int t = 0; t < nt; t += 2) {
            const bool last = (t == nt - 2);
            const char* a1 = cA + (size_t)(t + 1) * kstep;
            const char* a2 = last ? nA : cA + (size_t)(t + 2) * kstep; const char* b2 = last ? nB : cB + (size_t)(t + 2) * kstep;
            const char* a3 = a2 + kstep; const char* b3 = b2 + kstep;
            if (last && has_next) S.a_ready(nxt);
            if constexpr (SP2) {
            PG8_LDB(B0, 0, 0); PG8_LDB(B1, 0, 1); PG8_SCHED; PG8_LDA(At, 0, 0); PG8_STAGE(PG8_SA(1, 1), a1 + hstep, voffA);
            PG8_WAIT_V(8); PG8_WAIT_L(0); PG8_BAR; PG8_MMA(0, 0, At, B0); PG8_MMA(0, 1, At, B1); PG8_BAR; PG8_SCHED;
            PG8_LDA(At, 0, 1); PG8_STAGE(PG8_SB(0, 0), b2, voffB); PG8_STAGE(PG8_SB(0, 1), b2 + hstep, voffB); PG8_STAGE(PG8_SA(0, 0), a2, voffA);
            PG8_WAIT_V(8); PG8_WAIT_L(0); PG8_BAR; PG8_MMA(1, 0, At, B0); PG8_MMA(1, 1, At, B1); PG8_BAR; PG8_SCHED;
            PG8_LDB(B0, 1, 0); PG8_LDB(B1, 1, 1); PG8_SCHED; PG8_LDA(At, 1, 0); PG8_STAGE(PG8_SA(0, 1), a2 + hstep, voffA);
            PG8_WAIT_V(8); PG8_WAIT_L(0); PG8_BAR; PG8_MMA(0, 0, At, B0); PG8_MMA(0, 1, At, B1); PG8_BAR; PG8_SCHED;
            PG8_LDA(At, 1, 1); PG8_STAGE(PG8_SB(1, 0), b3, voffB); PG8_STAGE(PG8_SB(1, 1), b3 + hstep, voffB); PG8_STAGE(PG8_SA(1, 0), a3, voffA);
            PG8_WAIT_V(8); PG8_WAIT_L(0); PG8_BAR; PG8_MMA(1, 0, At, B0); PG8_MMA(1, 1, At, B1); PG8_BAR; PG8_SCHED;
            } else {
            PG8_LDB(B0, 0, 0); PG8_SCHED; PG8_LDA(At, 0, 0); PG8_STAGE(PG8_SA(1, 1), a1 + hstep, voffA);
            PG8_WAIT_L(8); PG8_BAR; PG8_WAIT_L(0); PG8_MMA(0, 0, At, B0); PG8_BAR; PG8_SCHED;
            PG8_LDB(B1, 0, 1); PG8_STAGE(PG8_SB(0, 0), b2, voffB);
            PG8_BAR; PG8_WAIT_L(0); PG8_MMA(0, 1, At, B1); PG8_BAR;
            PG8_LDA(At, 0, 1); PG8_STAGE(PG8_SA(0, 0), a2, voffA);
            PG8_BAR; PG8_WAIT_L(0); PG8_MMA(1, 0, At, B0); PG8_BAR; PG8_SCHED;
            PG8_STAGE(PG8_SB(0, 1), b2 + hstep, voffB);
            PG8_WAIT_V(6); PG8_BAR; PG8_MMA(1, 1, At, B1); PG8_BAR;
            PG8_LDB(B0, 1, 0); PG8_SCHED; PG8_LDA(At, 1, 0); PG8_STAGE(PG8_SA(0, 1), a2 + hstep, voffA);
            PG8_WAIT_L(8); PG8_BAR; PG8_WAIT_L(0); PG8_MMA(0, 0, At, B0); PG8_BAR; PG8_SCHED;
            PG8_LDB(B1, 1, 1); PG8_STAGE(PG8_SB(1, 0), b3, voffB);
            PG8_BAR; PG8_WAIT_L(0); PG8_MMA(0, 1, At, B1); PG8_BAR;
            PG8_LDA(At, 1, 1); PG8_STAGE(PG8_SA(1, 0), a3, voffA);
            PG8_BAR; PG8_WAIT_L(0); PG8_MMA(1, 0, At, B0); PG8_BAR; PG8_SCHED;
            PG8_STAGE(PG8_SB(1, 1), b3 + hstep, voffB);
            PG8_WAIT_V(6); PG8_BAR; PG8_MMA(1, 1, At, B1); PG8_BAR;
            }
        }
        if constexpr (ALIGN_EPI) { if (wr == 0) PG8_BAR; }
        if constexpr (!Epi::AFTER_DRAIN) { E(acc, cur, wr, wc, fr, fq); S.done(cur); }
        if (!has_next) break;
#pragma unroll
        for (int a = 0; a < 2; ++a)
#pragma unroll
            for (int b = 0; b < 2; ++b)
#pragma unroll
                for (int m = 0; m < 4; ++m)
#pragma unroll
                    for (int n = 0; n < 2; ++n) acc[a][b][m][n] = (f32x4){0.f, 0.f, 0.f, 0.f};
        cur = nxt; cA = nA; cB = nB; ++ui;
        if constexpr (ALIGN_EPI) { if (wr == 1) PG8_BAR; }
    }
    PG8_WAIT_V(0);
    if constexpr (!ALIGN_EPI) { if (wr == 0) PG8_BAR; }
    PG8_BAR;
    if constexpr (Epi::AFTER_DRAIN) { E.fused(acc, cur, wr, wc, fr, fq, lds, wid, lane); S.done(cur); }
#undef PG8_SA
#undef PG8_SB
#undef PG8_STAGE
#undef PG8_LDA
#undef PG8_LDB
#undef PG8_MMA
#undef PG8_WAIT_V
#undef PG8_WAIT_L
#undef PG8_BAR
#undef PG8_SCHED
}
}
namespace attn_body {
using bf16=__hip_bfloat16;
using bf16x8=__attribute__((ext_vector_type(8)))short;
using s16x4=__attribute__((ext_vector_type(4)))short;
using f32x16=__attribute__((ext_vector_type(16)))float;
using u32x4=__attribute__((ext_vector_type(4)))unsigned;
constexpr int BATCH=16,NHEAD=8,SEQ=2048,D=64,PQ=2304,PO=1024;
constexpr int NW=8,QBLK=32,QB=QBLK*NW,KVBLK=64,NQB=SEQ/QB;
constexpr int ATTN_UNIT_ROWS=QB;
__device__ __forceinline__ int crow(int r,int hi){return (r&3)+8*(r>>2)+4*hi;}
#define SBAR() __builtin_amdgcn_sched_barrier(0)
__device__ __forceinline__ void cmask(f32x16&p0,f32x16&p1,int jb,int qrel,int hi){
  const float NEG=-INFINITY; int kb=64*jb+4*hi;
  #pragma unroll
  for(int r=0;r<16;++r){int kv=kb+(r&3)+8*(r>>2); if(kv>qrel)p0[r]=NEG; if(kv+32>qrel)p1[r]=NEG;}
}

constexpr int NSLOT=3, SLOTB=8192;
constexpr int LDS_K=0, LDS_V=NSLOT*SLOTB, LDS_WS=2*NSLOT*SLOTB, LDS_OST=LDS_WS+NW*64*4, LDS_BYTES=LDS_OST+NW*4096;
constexpr float C2=0.125f*1.4426950408889634f;
__device__ __forceinline__ void glds16(const void*gsrc,unsigned lds_dst){unsigned keep;
  asm volatile("s_mov_b32 %0, m0\n\ts_mov_b32 m0, %2\n\ts_nop 0\n\tglobal_load_lds_dwordx4 %1, off\n\ts_mov_b32 m0, %0":"=&s"(keep):"v"(gsrc),"s"(lds_dst):"memory");}
__device__ __forceinline__ float max3f(float a,float b,float c){float r;asm("v_max3_f32 %0, %1, %2, %3":"=v"(r):"v"(a),"v"(b),"v"(c));return r;}
__device__ __forceinline__ float max2f(float a,float b){float r;asm("v_max_f32_e32 %0, %1, %2":"=v"(r):"v"(a),"v"(b));return r;}
__device__ __forceinline__ float fadd_s(float a,float b){float r;asm("v_add_f32_e32 %0, %1, %2":"=v"(r):"v"(a),"v"(b));return r;}
__device__ __forceinline__ float fsub_s(float a,float b){float r;asm("v_sub_f32_e32 %0, %1, %2":"=v"(r):"v"(a),"v"(b));return r;}
typedef float f32x2_t __attribute__((ext_vector_type(2))); typedef __bf16 bf16x2_t __attribute__((ext_vector_type(2)));
__device__ __forceinline__ unsigned cvtpk_s(float lo,float hi){f32x2_t v={lo,hi};bf16x2_t b=__builtin_convertvector(v,bf16x2_t);return __builtin_bit_cast(unsigned,b);}
#define WAIT_BAR(N) asm volatile("s_waitcnt vmcnt(" #N ") lgkmcnt(0)\n\ts_barrier":::"memory")

__device__ __forceinline__ void qkt(f32x16&p0,f32x16&p1,const char*Kslot,const bf16x8*qr,const f32x16&negm,int r32,int hi){
  const char*kb=Kslot+hi*1024+r32*16;
  #pragma unroll
  for(int d0=0;d0<4;++d0){
    const bf16x8 b0=*reinterpret_cast<const bf16x8*>(kb+d0*2048);
    const bf16x8 b1=*reinterpret_cast<const bf16x8*>(kb+d0*2048+512);
    if(d0==0){p0=__builtin_amdgcn_mfma_f32_32x32x16_bf16(b0,qr[0],negm,0,0,0);p1=__builtin_amdgcn_mfma_f32_32x32x16_bf16(b1,qr[0],negm,0,0,0);}
    else{p0=__builtin_amdgcn_mfma_f32_32x32x16_bf16(b0,qr[d0],p0,0,0,0);p1=__builtin_amdgcn_mfma_f32_32x32x16_bf16(b1,qr[d0],p1,0,0,0);}}
}
typedef __attribute__((address_space(3))) const char* lds_cptr;
typedef short v4i16_t __attribute__((ext_vector_type(4)));
__device__ __forceinline__ void kload8(bf16x8*kf,lds_cptr kp){
  kf[0]=*(const __attribute__((address_space(3))) bf16x8*)(kp);      kf[1]=*(const __attribute__((address_space(3))) bf16x8*)(kp+512);
  kf[2]=*(const __attribute__((address_space(3))) bf16x8*)(kp+2048); kf[3]=*(const __attribute__((address_space(3))) bf16x8*)(kp+2560);
  kf[4]=*(const __attribute__((address_space(3))) bf16x8*)(kp+4096); kf[5]=*(const __attribute__((address_space(3))) bf16x8*)(kp+4608);
  kf[6]=*(const __attribute__((address_space(3))) bf16x8*)(kp+6144); kf[7]=*(const __attribute__((address_space(3))) bf16x8*)(kp+6656);
}
__device__ __forceinline__ void kload2(bf16x8*kf,lds_cptr kp,int j){ kf[2*j]=*(const __attribute__((address_space(3))) bf16x8*)(kp+j*2048); kf[2*j+1]=*(const __attribute__((address_space(3))) bf16x8*)(kp+j*2048+512); }
__device__ __forceinline__ s16x4 vtr(lds_cptr p){ return __builtin_bit_cast(s16x4,__builtin_amdgcn_ds_read_tr16_b64_v4i16((__attribute__((address_space(3))) v4i16_t*)p)); }
__device__ __forceinline__ float rowmax(const f32x16&p0,const f32x16&p1){
  float a=max3f(p0[0],p0[1],p1[0]),b=max3f(p0[2],p0[3],p1[1]);a=max3f(a,p1[2],p1[3]);
  #pragma unroll
  for(int r=4;r<16;r+=4){a=max3f(a,p0[r],p0[r+1]);b=max3f(b,p0[r+2],p0[r+3]);a=max3f(a,p1[r],p1[r+1]);b=max3f(b,p1[r+2],p1[r+3]);}
  const float m=max2f(a,b);
  auto rr=__builtin_amdgcn_permlane32_swap(__float_as_uint(m),__float_as_uint(m),false,false);
  return max2f(__uint_as_float(rr[0]),__uint_as_float(rr[1]));
}
__device__ __forceinline__ void pv(f32x16*o,int vb,bf16x8 pa0,bf16x8 pa1,bf16x8 pa2,bf16x8 pa3){
  #pragma unroll
  for(int d0=0;d0<2;++d0){s16x4 lo[4],hi[4];
    #pragma unroll
    for(int ks=0;ks<4;++ks){
      asm volatile("ds_read_b64_tr_b16 %0,%1 offset:%c2":"=&v"(lo[ks]):"v"(vb),"i"(d0*4096+ks*1024):"memory");
      asm volatile("ds_read_b64_tr_b16 %0,%1 offset:%c2":"=&v"(hi[ks]):"v"(vb),"i"(d0*4096+ks*1024+512):"memory");}
    asm volatile("s_waitcnt lgkmcnt(0)":::"memory");SBAR();
    #define PK(k) (bf16x8){lo[k][0],lo[k][1],lo[k][2],lo[k][3],hi[k][0],hi[k][1],hi[k][2],hi[k][3]}
    o[d0]=__builtin_amdgcn_mfma_f32_32x32x16_bf16(pa0,PK(0),o[d0],0,0,0);
    o[d0]=__builtin_amdgcn_mfma_f32_32x32x16_bf16(pa1,PK(1),o[d0],0,0,0);
    o[d0]=__builtin_amdgcn_mfma_f32_32x32x16_bf16(pa2,PK(2),o[d0],0,0,0);
    o[d0]=__builtin_amdgcn_mfma_f32_32x32x16_bf16(pa3,PK(3),o[d0],0,0,0);
    #undef PK
  }
}

#ifndef ATTN_STORE16
#define ATTN_STORE16(p,v) (*(u32x4*)(p)=(v))
#endif
template<int THRL> __device__ __forceinline__ void attn_unit(int b,int qb,const bf16*Q,const bf16*__restrict__ K,const bf16*__restrict__ V,bf16*O,char*shm){
  int tid_=threadIdx.x; asm volatile("":"+v"(tid_)); const int tid=tid_,lane=tid&63,r32=lane&31,hi=lane>>5; const int wid=__builtin_amdgcn_readfirstlane(tid>>6);
  const long rowbase=(long)b*SEQ; const int q0=qb*QB;
  const bf16*Qw=Q+(rowbase+q0+wid*QBLK)*PQ;
  const bf16*Kh=K+rowbase*PQ,*Vh=V+rowbase*PQ;
  const unsigned lds0=(unsigned)(uintptr_t)shm;
  float*wsf=(float*)(shm+LDS_WS)+wid*64;
  const bf16*ksrc=Kh+(long)lane*PQ+wid*8;
  const bf16*vsrc=Vh+(long)(16*(wid&3)+(lane>>2))*PQ+(wid>>2)*32+(lane&3)*8;
  const unsigned kdst=lds0+LDS_K+wid*1024, vdst=lds0+LDS_V+wid*1024;
  #define DMA_K(t,slot) glds16(ksrc+(long)(t)*KVBLK*PQ,(unsigned)__builtin_amdgcn_readfirstlane(kdst+(slot)))
  #define DMA_V(t,slot) glds16(vsrc+(long)(t)*KVBLK*PQ,(unsigned)__builtin_amdgcn_readfirstlane(vdst+(slot)))
  const int vb0=(int)(lds0+LDS_V)+((lane>>4)&1)*32+(lane&3)*8+(4*hi+((lane&15)>>2))*64;
  const char*Kbase=shm+LDS_K; bf16x8 kf[8];
  const lds_cptr shm3=(lds_cptr)shm; const lds_cptr kp0=shm3+LDS_K+hi*1024+r32*16; const lds_cptr vp0=shm3+LDS_V+((lane>>4)&1)*32+(lane&3)*8+(4*hi+((lane&15)>>2))*64;
  int NT=SEQ/KVBLK; asm volatile("":"+s"(NT));
  DMA_K(0,0);DMA_V(0,0);DMA_K(1,SLOTB);
  bf16x8 qr[4];
  #pragma unroll
  for(int d0=0;d0<4;++d0)qr[d0]=*reinterpret_cast<const bf16x8*>(&Qw[(long)r32*PQ+d0*16+hi*8]);
  float mhat=0.f,l_reg=0.f;f32x16 o[2];o[0]=f32x16{};o[1]=f32x16{};f32x16 negm=f32x16{};asm volatile("":"+v"(negm));
    #define CMASK(P0,P1,t) do{}while(0)
  bool resc=false;
  #define START(P0,P1) do{ const float rm=rowmax(P0,P1); resc=false; \
    { const float dl=rm; mhat=fadd_s(mhat,dl); \
      _Pragma("unroll") for(int r=0;r<16;++r){P0[r]=fsub_s(P0[r],dl);P1[r]=fsub_s(P1[r],dl);} \
      _Pragma("unroll") for(int r=0;r<16;++r)negm[r]=-mhat; asm volatile("":"+v"(negm)); } \
    _Pragma("unroll") for(int r=0;r<16;++r)P0[r]=__builtin_amdgcn_exp2f(P0[r]); }while(0)
  #define RESC() do{ if(resc){ asm volatile("s_waitcnt lgkmcnt(0)":::"memory"); \
      _Pragma("unroll") for(int d_=0;d_<2;++d_) _Pragma("unroll") for(int r=0;r<16;++r)o[d_][r]*=wsf[crow(r,hi)]; } }while(0)
  f32x16 pA0,pA1,pB0,pB1;
  int sl_prev=0,sl_cur=0,sl_next=SLOTB;
  #define ROT() do{sl_prev=sl_cur;sl_cur=sl_next;sl_next=(sl_next==(NSLOT-1)*SLOTB)?0:sl_next+SLOTB;}while(0)
  DMA_K(2,2*SLOTB);
  WAIT_BAR(3);
  qkt(pA0,pA1,Kbase,qr,negm,r32,hi);asm volatile("s_nop 15\n\ts_nop 7":"+v"(pA0),"+v"(pA1));CMASK(pA0,pA1,0);
  START(pA0,pA1);
  _Pragma("unroll") for(int r=0;r<16;++r)pA1[r]=__builtin_amdgcn_exp2f(pA1[r]);
  WAIT_BAR(0);
  DMA_K(3,0);DMA_V(1,SLOTB);
  ROT();
  kload8(kf,kp0+sl_cur);
  WAIT_BAR(2);
  s16x4 vlo[8],vhi[8]; u32x4 pw0,pw1,pw2,pw3;
  #define PKW(P,B) cvtpk_s(P[B],P[B+1])
  #define PAF(k) __builtin_bit_cast(bf16x8,pw##k)
  #define VFR(i) (bf16x8){vlo[i][0],vlo[i][1],vlo[i][2],vlo[i][3],vhi[i][0],vhi[i][1],vhi[i][2],vhi[i][3]}
  #define PIN(x) asm volatile("":"+v"(x))
  #define MX3(a,b,c) __builtin_fmaxf(__builtin_fmaxf((a),(b)),(c))
  #define GAPA(MF,A0,A1,A2,A3,W0,W1,PW) do{ MF; sacc+=A0; sacc+=A1; sacc+=A2; sacc+=A3; PIN(sacc); W0; W1; PIN(PW); SBAR(); }while(0)
  #define EX(v) __builtin_amdgcn_exp2f(v)
  #define GAPB(MF,X,B) do{ MF; X[B]=EX(X[B]); X[B+1]=EX(X[B+1]); X[B+2]=EX(X[B+2]); X[B+3]=EX(X[B+3]); PIN(X); SBAR(); }while(0)
  #define VRD(i) do{ vlo[i]=vtr(vp_+(((i)>>2)*4096+((i)&3)*1024)); vhi[i]=vtr(vp_+(((i)>>2)*4096+((i)&3)*1024+512)); }while(0)
  #define KRD(G,j) do{ if(G){ kload2(kf,kp0+sl_next,j); SBAR(); } }while(0)
  #define STEP(C0,C1,P0,P1,t,GK,GV,GL) do{ SBAR(); \
    const lds_cptr vp_=vp0+sl_prev; \
    VRD(0); SBAR(); float sacc=(P0[0]+P0[1]); \
    GAPA(C0=__builtin_amdgcn_mfma_f32_32x32x16_bf16(kf[0],qr[0],negm,0,0,0), P0[2],P0[3],P0[4],P0[5],     pw0[0]=PKW(P0,0), pw0[1]=PKW(P0,2), pw0); \
    VRD(4); SBAR(); GAPA(C1=__builtin_amdgcn_mfma_f32_32x32x16_bf16(kf[1],qr[0],negm,0,0,0), P0[6],P0[7],P0[8],P0[9],     pw0[2]=PKW(P0,4), pw0[3]=PKW(P0,6), pw0); \
    VRD(1); SBAR(); GAPA(C0=__builtin_amdgcn_mfma_f32_32x32x16_bf16(kf[2],qr[1],C0,0,0,0),   P0[10],P0[11],P0[12],P0[13], pw1[0]=PKW(P0,8), pw1[1]=PKW(P0,10), pw1); \
    VRD(5); SBAR(); GAPA(C1=__builtin_amdgcn_mfma_f32_32x32x16_bf16(kf[3],qr[1],C1,0,0,0),   P0[14],P0[15],P1[0],P1[1],   pw1[2]=PKW(P0,12),pw1[3]=PKW(P0,14), pw1); \
    VRD(2); SBAR(); GAPA(C0=__builtin_amdgcn_mfma_f32_32x32x16_bf16(kf[4],qr[2],C0,0,0,0),   P1[2],P1[3],P1[4],P1[5],     pw2[0]=PKW(P1,0), pw2[1]=PKW(P1,2), pw2); \
    VRD(6); SBAR(); GAPA(C1=__builtin_amdgcn_mfma_f32_32x32x16_bf16(kf[5],qr[2],C1,0,0,0),   P1[6],P1[7],P1[8],P1[9],     pw2[2]=PKW(P1,4), pw2[3]=PKW(P1,6), pw2); \
    VRD(3); SBAR(); GAPA(C0=__builtin_amdgcn_mfma_f32_32x32x16_bf16(kf[6],qr[3],C0,0,0,0),   P1[10],P1[11],P1[12],P1[13], pw3[0]=PKW(P1,8), pw3[1]=PKW(P1,10), pw3); \
    VRD(7); SBAR(); GAPA(C1=__builtin_amdgcn_mfma_f32_32x32x16_bf16(kf[7],qr[3],C1,0,0,0),   P1[14],P1[15],0.f,0.f,       pw3[2]=PKW(P1,12),pw3[3]=PKW(P1,14), pw3); \
    l_reg+=sacc; \
    if(GK){DMA_K((t)+3,sl_cur);} if(GV){DMA_V((t)+1,sl_next);} \
    CMASK(C0,C1,t); \
    { float a=MX3(C0[0],C0[1],C1[0]),b=MX3(C0[2],C0[3],C1[1]); a=MX3(a,C1[2],C1[3]); \
      _Pragma("unroll") for(int r=4;r<16;r+=4){a=MX3(a,C0[r],C0[r+1]);b=MX3(b,C0[r+2],C0[r+3]);a=MX3(a,C1[r],C1[r+1]);b=MX3(b,C1[r+2],C1[r+3]);} \
      float rm=__builtin_fmaxf(a,b); { auto rr=__builtin_amdgcn_permlane32_swap(__float_as_uint(rm),__float_as_uint(rm),false,false); rm=__builtin_fmaxf(__uint_as_float(rr[0]),__uint_as_float(rr[1])); } \
      resc=false; \
      if(__builtin_expect(__any(rm>(float)THRL),0)){ const float dl=__builtin_fmaxf(rm,0.f); mhat+=dl; \
        _Pragma("unroll") for(int r=0;r<16;++r){C0[r]-=dl;C1[r]-=dl;} \
        _Pragma("unroll") for(int r=0;r<16;++r)negm[r]=-mhat; asm volatile("":"+v"(negm)); \
        const float f=__builtin_amdgcn_exp2f(-dl); l_reg*=f; if(hi==0)wsf[r32]=f; resc=true; } } \
    SBAR(); \
    GAPB(o[0]=__builtin_amdgcn_mfma_f32_32x32x16_bf16(PAF(0),VFR(0),o[0],0,0,0), C0,0); \
    GAPB(o[1]=__builtin_amdgcn_mfma_f32_32x32x16_bf16(PAF(0),VFR(4),o[1],0,0,0), C0,4); \
    KRD(GL,0); GAPB(o[0]=__builtin_amdgcn_mfma_f32_32x32x16_bf16(PAF(1),VFR(1),o[0],0,0,0), C0,8); \
    KRD(GL,1); GAPB(o[1]=__builtin_amdgcn_mfma_f32_32x32x16_bf16(PAF(1),VFR(5),o[1],0,0,0), C0,12); \
    KRD(GL,2); GAPB(o[0]=__builtin_amdgcn_mfma_f32_32x32x16_bf16(PAF(2),VFR(2),o[0],0,0,0), C1,0); \
    KRD(GL,3); GAPB(o[1]=__builtin_amdgcn_mfma_f32_32x32x16_bf16(PAF(2),VFR(6),o[1],0,0,0), C1,4); \
    GAPB(o[0]=__builtin_amdgcn_mfma_f32_32x32x16_bf16(PAF(3),VFR(3),o[0],0,0,0), C1,8); \
    GAPB(o[1]=__builtin_amdgcn_mfma_f32_32x32x16_bf16(PAF(3),VFR(7),o[1],0,0,0), C1,12); \
    }while(0)
  int t=1;
  #undef CMASK
  #define CMASK(P0,P1,t) do{}while(0)
  for(;t+5<NT;t+=2){
    STEP(pB0,pB1,pA0,pA1,t,true,true,true);     WAIT_BAR(2); RESC(); ROT();
    STEP(pA0,pA1,pB0,pB1,t+1,true,true,true);   WAIT_BAR(2); RESC(); ROT();
  }
  #undef CMASK
  #define CMASK(P0,P1,t) do{}while(0)
  #define ENDW(tt) do{ if((tt)+3<NT){WAIT_BAR(2);} else if((tt)+2<NT){WAIT_BAR(1);} else {WAIT_BAR(0);} }while(0)
  for(;t+1<NT;t+=2){
    STEP(pB0,pB1,pA0,pA1,t,(t+3<NT),(t+1<NT),(t+1<NT));       ENDW(t);   RESC(); ROT();
    STEP(pA0,pA1,pB0,pB1,t+1,(t+4<NT),(t+2<NT),(t+2<NT));     ENDW(t+1); RESC(); ROT();
  }
  STEP(pB0,pB1,pA0,pA1,NT-1,false,false,false); RESC();
  { float sacc=pB0[0]+pB0[1]; _Pragma("unroll") for(int r=2;r<16;++r)sacc+=pB0[r]; _Pragma("unroll") for(int r=0;r<16;++r)sacc+=pB1[r]; l_reg+=sacc;
    pw0=(u32x4){PKW(pB0,0),PKW(pB0,2),PKW(pB0,4),PKW(pB0,6)};pw1=(u32x4){PKW(pB0,8),PKW(pB0,10),PKW(pB0,12),PKW(pB0,14)};pw2=(u32x4){PKW(pB1,0),PKW(pB1,2),PKW(pB1,4),PKW(pB1,6)};pw3=(u32x4){PKW(pB1,8),PKW(pB1,10),PKW(pB1,12),PKW(pB1,14)};
    SBAR(); pv(o,vb0+sl_cur,PAF(0),PAF(1),PAF(2),PAF(3)); }
  #undef PKW
  #undef PAF
  #undef VFR
  #undef PIN
  #undef MX3
  #undef GAPA
  #undef GAPB
  #undef EX
  #undef VRD
  #undef KRD
  #undef STEP
  #undef ENDW
  {auto rr=__builtin_amdgcn_permlane32_swap(__float_as_uint(l_reg),__float_as_uint(l_reg),false,false);l_reg=__uint_as_float(rr[0])+__uint_as_float(rr[1]);}
  if(hi==0)wsf[32+r32]=l_reg;asm volatile("s_waitcnt lgkmcnt(0)":::"memory");
  float rli[16];
  #pragma unroll
  for(int r=0;r<16;++r)rli[r]=__builtin_amdgcn_rcpf(wsf[32+crow(r,hi)]);
  bf16*Ow=O+(rowbase+q0+wid*QBLK)*PO;
  { bf16*stg=(bf16*)(shm+LDS_OST)+wid*2048;
    #pragma unroll
    for(int r=0;r<16;++r){const int orow=crow(r,hi);
      #pragma unroll
      for(int d0=0;d0<2;++d0)stg[orow*64+d0*32+r32]=__float2bfloat16(o[d0][r]*rli[r]);}
    asm volatile("s_waitcnt lgkmcnt(0)":::"memory");
    #pragma unroll
    for(int i=0;i<4;++i){const int row=i*8+(lane>>3),ch=lane&7; const u32x4 v=*(const u32x4*)(stg+row*64+ch*8); ATTN_STORE16(Ow+(long)row*PO+ch*8,v);} }
  asm volatile("s_waitcnt lgkmcnt(0)\n\ts_barrier":::"memory");
  #undef DMA_K
  #undef DMA_V
  #undef CMASK
  #undef START
  #undef RESC
  #undef ROT
}
constexpr int ATTN_LDS_BYTES=LDS_BYTES;
#undef SBAR
#undef WAIT_BAR
}
namespace cg = cooperative_groups;
constexpr int NWAVES = 8;
constexpr int M = 32768, DMODEL = 1024, DFF = 2816, SEQ = 2048, EV_IN = 2304, OD_IN = 1536;
constexpr float EPS = 1e-6f;
constexpr size_t MiB = 1u << 20;
constexpr size_t WS_SSQ = 432 * MiB;
constexpr size_t WS_SGUW = 2 * MiB;
constexpr size_t WS_W1T = 4 * MiB;
constexpr size_t WS_W2T = 92 * MiB;
constexpr size_t WS_EVIN = 136 * MiB;
constexpr size_t WS_EVOUT = 145 * MiB;
constexpr size_t WS_ODIN = 149 * MiB;
constexpr size_t WS_ODOUT = 155 * MiB;
constexpr size_t WS_XB = 160 * MiB;
constexpr size_t WS_ACT = 224 * MiB;
constexpr size_t WS_PROJ = 224 * MiB;
constexpr size_t WS_MIX = 368 * MiB;
constexpr size_t WS_BAR = 440 * MiB, BAR_BYTES = 16384;
constexpr size_t WS_END = 441 * MiB;
constexpr int RING_BYTES = 131072, PTAB_BYTES = 4096, MISC_OFF = RING_BYTES + PTAB_BYTES, LDS_BYTES = 147456;

#define GAS __attribute__((address_space(1)))
#define LAS __attribute__((address_space(3)))
typedef unsigned short bf16;
typedef unsigned v4u __attribute__((ext_vector_type(4)));
typedef unsigned v2u __attribute__((ext_vector_type(2)));
typedef float f32x4 __attribute__((ext_vector_type(4)));
typedef short bf16x8 __attribute__((ext_vector_type(8)));
#define LDS_WAIT() asm volatile("s_waitcnt lgkmcnt(0)" ::: "memory")
__device__ __forceinline__ unsigned f2bf(float f) { unsigned u = __builtin_bit_cast(unsigned, f); return (u + 0x7fffu + ((u >> 16) & 1u)) >> 16; }
__device__ __forceinline__ unsigned pk2(float lo, float hi) { return pg8::cvt_pk_bf16(lo, hi); }
__device__ __forceinline__ float bflo(unsigned u) { return __builtin_bit_cast(float, u << 16); }
__device__ __forceinline__ float bfhi(unsigned u) { return __builtin_bit_cast(float, u & 0xffff0000u); }
#define UNPACK8(X_, W_) do { X_[0] = bflo(W_[0]); X_[1] = bfhi(W_[0]); X_[2] = bflo(W_[1]); X_[3] = bfhi(W_[1]); X_[4] = bflo(W_[2]); X_[5] = bfhi(W_[2]); X_[6] = bflo(W_[3]); X_[7] = bfhi(W_[3]); } while (0)
__device__ __forceinline__ float gelu_tanh(float x) {
    const float z2 = 1.5957691216057308f * (x + 0.044715f * x * x * x);
    return x * __builtin_amdgcn_rcpf(1.0f + __builtin_amdgcn_exp2f(-1.4426950408889634f * z2));
}
__device__ __forceinline__ float wave_sum(float v) {
#pragma unroll
    for (int o = 1; o < 64; o <<= 1) v += __shfl_xor(v, o);
    return v;
}

struct Args { const float* in[21]; float* out; unsigned char* ws; };
#define XB_TMO      128
#define XB_XCNT(j)  (256  + 64 * (j))
#define XB_XSUB(j)  (1280 + 64 * (j))
#define XB_XGEN(j)  (2304 + 64 * (j))
#define XB_TOP      3328
#define XB_TOPGEN   3392
#define XCD_BAR_WORDS 3456
#define XB_SPIN_CAP (1u << 18)

__device__ __forceinline__ unsigned xb_ld(unsigned* p)              { return __hip_atomic_load(p, __ATOMIC_RELAXED, __HIP_MEMORY_SCOPE_AGENT); }
__device__ __forceinline__ unsigned xb_add(unsigned* p, unsigned v) { return __hip_atomic_fetch_add(p, v, __ATOMIC_RELAXED, __HIP_MEMORY_SCOPE_AGENT); }
__device__ __forceinline__ unsigned xb_xcc_id() { return (unsigned)__builtin_amdgcn_s_getreg((3 << 11) | 20) & 0xFu; }
#define XB_SPIN(cond, bar) do { unsigned _sp = 0; while (cond) { __builtin_amdgcn_s_sleep(1); \
    if ((++_sp & 255u) == 0u) { if (xb_ld(&(bar)[XB_TMO])) break; if (_sp > XB_SPIN_CAP) { atomicAdd(&(bar)[XB_TMO], 1u); break; } } } } while (0)

struct XcdBarrier {
    unsigned* bar; unsigned x;
    volatile LAS unsigned* st;
};

__device__ __forceinline__ XcdBarrier xcd_barrier_post(unsigned* bar, volatile LAS unsigned* st) {
    XcdBarrier b; b.bar = bar; b.x = xb_xcc_id(); b.st = st;
    if (threadIdx.x == 0) (void)xb_add(&bar[XB_XCNT(b.x)], 1u);
    return b;
}
__device__ __forceinline__ void xcd_barrier_complete(unsigned* bar, unsigned x, unsigned& nloc, unsigned& nx) {
    const unsigned G = gridDim.x * gridDim.y * gridDim.z;
    unsigned sum, cnt, mine, sp = 0u;
    for (;;) {
        sum = 0u; cnt = 0u; mine = 0u;
#pragma unroll
        for (unsigned j = 0; j < 16; ++j) { const unsigned c = xb_ld(&bar[XB_XCNT(j)]); sum += c; cnt += (c > 0u) ? 1u : 0u; mine = (j == x) ? c : mine; }
        if (sum == G) break;
        __builtin_amdgcn_s_sleep(1);
        if ((++sp & 255u) == 0u) { if (xb_ld(&bar[XB_TMO])) break; if (sp > XB_SPIN_CAP) { atomicAdd(&bar[XB_TMO], 1u); break; } }
    }
    nloc = mine > 0u ? mine : 1u; nx = cnt > 0u ? cnt : 1u;
}

__device__ __forceinline__ void xcd_barrier(const XcdBarrier& b) {
    asm volatile("s_waitcnt vmcnt(0)" ::: "memory");
    __syncthreads();
    if (threadIdx.x == 0) {
        unsigned* bar = b.bar;
        __builtin_amdgcn_s_waitcnt(0);
        unsigned nloc = b.st[0], nx = b.st[1];
        if (nloc == 0u) { xcd_barrier_complete(bar, b.x, nloc, nx); b.st[0] = nloc; b.st[1] = nx; }
        const unsigned old = xb_add(&bar[XB_XSUB(b.x)], 1u);
        const unsigned gen = old / nloc;
        if (old + 1u == (gen + 1u) * nloc) {
            __builtin_amdgcn_fence(__ATOMIC_RELEASE, "agent");
            asm volatile("s_waitcnt vmcnt(0)" ::: "memory");
            const unsigned og = xb_add(&bar[XB_TOP], 1u);
            const unsigned tg = og / nx;
            if (og + 1u == (tg + 1u) * nx) xb_add(&bar[XB_TOPGEN], 1u);
            else XB_SPIN(xb_ld(&bar[XB_TOPGEN]) == tg, bar);
            __builtin_amdgcn_fence(__ATOMIC_ACQUIRE, "agent");
            xb_add(&bar[XB_XGEN(b.x)], 1u);
            asm volatile("s_waitcnt vmcnt(0)" ::: "memory");
        } else {
            XB_SPIN(xb_ld(&bar[XB_XGEN(b.x)]) == gen, bar);
            __builtin_amdgcn_fence(__ATOMIC_ACQUIRE, "agent");
            asm volatile("s_waitcnt vmcnt(0)" ::: "memory");
        }
    }
    __syncthreads();
}


enum { I_X = 0, I_F1N, I_F1WI, I_F1WO, I_MIXN, I_F2N, I_F2WI, I_F2WO, I_EVWI, I_EVCONV, I_EVQN, I_EVKN, I_EVWO, I_ODWI, I_ODPW, I_ODPS, I_ODSN, I_ODSW, I_ODSB, I_ODWO, I_FINN };

__device__ __forceinline__ void tr_item(const float* W, int ldw, const float* gain, bf16* WT, int dstK, int koff, int k0, int n0, int drow, LAS float* scr, int lane) {
#pragma unroll 16
    for (int i = 0; i < 32; ++i) { const int kk = 2 * i + (lane >> 5); float w = W[(size_t)(k0 + kk) * ldw + n0 + (lane & 31)]; if (gain) w *= gain[k0 + kk]; scr[kk * 33 + (lane & 31)] = w; }
    LDS_WAIT(); asm volatile("" ::: "memory");
    const int c = lane & 7;
#pragma unroll
    for (int j = 0; j < 4; ++j) { const int n = (lane >> 3) + 8 * j; const LAS float* s = scr + (8 * c) * 33 + n;
        v4u o; o.x = pk2(s[0 * 33], s[1 * 33]); o.y = pk2(s[2 * 33], s[3 * 33]); o.z = pk2(s[4 * 33], s[5 * 33]); o.w = pk2(s[6 * 33], s[7 * 33]);
        *(GAS v4u*)(WT + (size_t)(drow + n) * dstK + koff + k0 + 8 * c) = o; }
    LDS_WAIT(); asm volatile("" ::: "memory");
}

__device__ __forceinline__ void p0_prologue(const Args& a, LAS unsigned char* lds, int gw, int NGW, int gtid, int GT, int wave, int lane) {
    unsigned char* ws = a.ws;
    LAS float* scr = (LAS float*)(lds + wave * 16384);
    constexpr int N_W1 = 8 * 2816, N_W2 = 8 * 1408, N_EI = 2 * 1152, N_EO = 2 * 512, N_OI = 2 * 768, N_OO = 2 * 256, NITEMS = N_W1 + N_W2 + N_EI + N_EO + N_OI + N_OO;
    for (int it = gw; it < NITEMS; it += NGW) {
        int r = it; const float* W; const float* gain = nullptr; bf16* WT; int ldw, dstK, koff = 0, nblk, mode = 0;
        if (r < N_W1) { const int m = r / 2816; r -= m * 2816; const int l = m & 3, f2 = m >> 2; W = a.in[f2 ? I_F2WI : I_F1WI] + (size_t)l * 1024 * 5632; gain = a.in[f2 ? I_F2N : I_F1N] + l * 1024;
            WT = (bf16*)(ws + WS_W1T) + (size_t)m * 5632 * 1024; ldw = 5632; dstK = 1024; nblk = 176; mode = 1; }
        else if ((r -= N_W1) < N_W2) { const int m = r / 1408; r -= m * 1408; const int l = m & 3, f2 = m >> 2; W = a.in[f2 ? I_F2WO : I_F1WO] + (size_t)l * 2816 * 1024;
            WT = (bf16*)(ws + WS_W2T) + (size_t)m * 1024 * 2816; ldw = 1024; dstK = 2816; nblk = 32; }
        else if ((r -= N_W2) < N_EI) { const int j = r / 1152; r -= j * 1152; W = a.in[I_EVWI] + (size_t)j * 1024 * 2304; gain = a.in[I_MIXN] + (2 * j) * 1024;
            WT = (bf16*)(ws + WS_EVIN) + (size_t)j * 2304 * 1024; ldw = 2304; dstK = 1024; nblk = 72; }
        else if ((r -= N_EI) < N_EO) { const int j = r / 512; r -= j * 512; W = a.in[I_EVWO] + (size_t)j * 1024 * 1024;
            WT = (bf16*)(ws + WS_EVOUT) + (size_t)j * 1024 * 1024; ldw = 1024; dstK = 1024; nblk = 32; }
        else if ((r -= N_EO) < N_OI) { const int j = r / 768; r -= j * 768; W = a.in[I_ODWI] + (size_t)j * 1024 * 1536; gain = a.in[I_MIXN] + (2 * j + 1) * 1024;
            WT = (bf16*)(ws + WS_ODIN) + (size_t)j * 1536 * 1024; ldw = 1536; dstK = 1024; nblk = 48; }
        else { r -= N_OI; const int j = r / 256; r -= j * 256; W = a.in[I_ODWO] + (size_t)j * 1024 * 1024 + (size_t)512 * 1024;
            WT = (bf16*)(ws + WS_ODOUT) + (size_t)j * 1024 * 1024; ldw = 1024; dstK = 1024; koff = 512; nblk = 32; }
        const int kb = r / nblk, nb = r - kb * nblk, k0 = 64 * kb, n0 = 32 * nb;
        int drow = n0;
        if (mode == 1) { const int nn = n0 < 2816 ? n0 : n0 - 2816; drow = (nn >> 7) * 256 + (nn & 127) + (n0 < 2816 ? 0 : 128); }
        tr_item(W, ldw, gain, WT, dstK, koff, k0, n0, drow, scr, lane);
    }
    for (int it = gw; it < 2048; it += NGW) {
        const int j = it >> 10, g = (it >> 8) & 3, cb = (it >> 4) & 15, n = (it & 15) * 64 + lane;
        const float* pw = a.in[I_ODPW] + ((size_t)(j * 4 + g) * 128 + cb * 8) * 128; const float* sc = a.in[I_ODPS] + j * 512 + g * 128; const float* wo = a.in[I_ODWO] + (size_t)j * 1024 * 1024 + (size_t)(g * 128) * 1024 + n;
        float acc[8];
#pragma unroll
        for (int e = 0; e < 8; ++e) acc[e] = 0.f;
        for (int d0 = 0; d0 < 128; d0 += 16) { float wv[16];
#pragma unroll
            for (int d = 0; d < 16; ++d) wv[d] = wo[(size_t)(d0 + d) * 1024];
#pragma unroll
            for (int d = 0; d < 16; ++d) { const float w = wv[d] * sc[d0 + d];
#pragma unroll
                for (int e = 0; e < 8; ++e) acc[e] += pw[e * 128 + d0 + d] * w; } }
        v4u o; o.x = pk2(acc[0], acc[1]); o.y = pk2(acc[2], acc[3]); o.z = pk2(acc[4], acc[5]); o.w = pk2(acc[6], acc[7]);
        *(v4u*)((bf16*)(ws + WS_ODOUT) + (size_t)j * 1024 * 1024 + (size_t)n * 1024 + g * 128 + cb * 8) = o;
    }
    { const float* x = a.in[I_X]; bf16* xb = (bf16*)(ws + WS_XB); float* ssq0 = (float*)(ws + WS_SSQ);
      for (int m = gw; m < M; m += NGW) { const f32x4* xr = (const f32x4*)(x + (size_t)m * 1024) + lane; f32x4 v[4]; float s = 0.f;
#pragma unroll
          for (int j = 0; j < 4; ++j) { v[j] = xr[64 * j]; s += (v[j].x * v[j].x + v[j].y * v[j].y) + (v[j].z * v[j].z + v[j].w * v[j].w); }
          s = wave_sum(s); if (lane == 0) *(f32x4*)(ssq0 + 4 * (size_t)m) = (f32x4){s, 0.f, 0.f, 0.f};
          v2u* o8 = (v2u*)(xb + (size_t)m * 1024) + lane;
#pragma unroll
          for (int j = 0; j < 4; ++j) { v2u w; w.x = pk2(v[j].x, v[j].y); w.y = pk2(v[j].z, v[j].w); o8[64 * j] = w; } } }
    { const f32x4* s = (const f32x4*)a.in[I_ODSW]; v2u* o = (v2u*)(ws + WS_SGUW); for (int i = gtid; i < 2 * 4 * 128 * 128 / 4; i += GT) { const f32x4 v = s[i]; v2u w; w.x = pk2(v.x, v.y); w.y = pk2(v.z, v.w); o[i] = w; } }
}

__device__ __forceinline__ void even_prep(bf16* proj, bf16* mix, const float* qg, const float* kg, const float* convw, int gtid, int GT) {
    for (int it = gtid; it < M * 80; it += GT) {
        const int tok = it / 80, r = it - tok * 80, h = r >> 3, sub = r & 7;
        bf16* p = proj + (size_t)tok * EV_IN + 1536 + h * 64 + sub * 8;
        const v4u w = *(const v4u*)p; float x[8]; UNPACK8(x, w);
        float s = 0.f;
#pragma unroll
        for (int e = 0; e < 8; ++e) s += x[e] * x[e];
        s += __shfl_xor(s, 1); s += __shfl_xor(s, 2); s += __shfl_xor(s, 4);
        const float rs = __builtin_amdgcn_rsqf(s * (1.0f / 64.0f) + EPS);
        const float* gn = (h < 8 ? qg : kg) + sub * 8;
        const f32x4 g0 = *(const f32x4*)gn, g1 = *(const f32x4*)(gn + 4);
        const float gv[8] = {g0.x, g0.y, g0.z, g0.w, g1.x, g1.y, g1.z, g1.w};
        const int t = tok & (SEQ - 1); const float pos = (float)(sub < 4 ? (t >> 6) : (t & 63));
        const float osc = h < 8 ? attn_body::C2 : 1.0f;
        float o[8];
#pragma unroll
        for (int e = 0; e < 4; ++e) { const int j = (sub & 3) * 4 + e; const float inv = __builtin_amdgcn_exp2f(-(float)j * 0.83048202372184059f);
            const float ang = pos * inv, c = __cosf(ang), sn = __sinf(ang);
            const float x0 = x[2 * e] * rs * gv[2 * e], x1 = x[2 * e + 1] * rs * gv[2 * e + 1];
            o[2 * e] = (x0 * c - x1 * sn) * osc; o[2 * e + 1] = (x0 * sn + x1 * c) * osc; }
        v4u ow; ow.x = pk2(o[0], o[1]); ow.y = pk2(o[2], o[3]); ow.z = pk2(o[4], o[5]); ow.w = pk2(o[6], o[7]);
        *(v4u*)p = ow;
    }
    for (int it = gtid; it < M * 64; it += GT) {
        const int tok = it >> 6, c = (it & 63) * 8, t = tok & (SEQ - 1);
        const bf16* pr = proj + (size_t)tok * EV_IN + c;
        const v4u zero = (v4u){0u, 0u, 0u, 0u};
        const v4u wb = *(const v4u*)pr, wc1 = *(const v4u*)(pr + 512), wh1 = *(const v4u*)(pr + 1024);
        const v4u wc0 = t > 0 ? *(const v4u*)(pr - EV_IN + 512) : zero, wh0 = t > 0 ? *(const v4u*)(pr - EV_IN + 1024) : zero;
        const v4u wc2 = t < SEQ - 1 ? *(const v4u*)(pr + EV_IN + 512) : zero, wh2 = t < SEQ - 1 ? *(const v4u*)(pr + EV_IN + 1024) : zero;
        float gb[8], c0[8], h0[8], c1[8], h1[8], c2[8], h2[8];
        UNPACK8(gb, wb); UNPACK8(c0, wc0); UNPACK8(h0, wh0); UNPACK8(c1, wc1); UNPACK8(h1, wh1); UNPACK8(c2, wc2); UNPACK8(h2, wh2);
        const f32x4 a0 = *(const f32x4*)(convw + c), a1 = *(const f32x4*)(convw + c + 4), b0 = *(const f32x4*)(convw + 512 + c), b1 = *(const f32x4*)(convw + 512 + c + 4), d0 = *(const f32x4*)(convw + 1024 + c), d1 = *(const f32x4*)(convw + 1024 + c + 4);
        const float w0[8] = {a0.x, a0.y, a0.z, a0.w, a1.x, a1.y, a1.z, a1.w}, w1[8] = {b0.x, b0.y, b0.z, b0.w, b1.x, b1.y, b1.z, b1.w}, w2[8] = {d0.x, d0.y, d0.z, d0.w, d1.x, d1.y, d1.z, d1.w};
        float o[8];
#pragma unroll
        for (int e = 0; e < 8; ++e) o[e] = gb[e] * (w0[e] * (c0[e] * h0[e]) + w1[e] * (c1[e] * h1[e]) + w2[e] * (c2[e] * h2[e]));
        v4u ow; ow.x = pk2(o[0], o[1]); ow.y = pk2(o[2], o[3]); ow.z = pk2(o[4], o[5]); ow.w = pk2(o[6], o[7]);
        *(v4u*)(mix + (size_t)tok * 1024 + c) = ow;
    }
}

template <int R> __device__ __forceinline__ void pool_item(const bf16* pb, bf16* mp, int t) {
    v4u w[2 * R + 1];
#pragma unroll
    for (int d = 0; d <= 2 * R; ++d) { const int tt = t + d - R; w[d] = (tt >= 0 && tt < SEQ) ? *(const v4u*)(pb + (size_t)tt * OD_IN) : (v4u){0u, 0u, 0u, 0u}; }
    float acc[8];
#pragma unroll
    for (int e = 0; e < 8; ++e) acc[e] = 0.f;
#pragma unroll
    for (int d = 0; d <= 2 * R; ++d) { float x[8]; UNPACK8(x, w[d]);
#pragma unroll
        for (int e = 0; e < 8; ++e) acc[e] += x[e]; }
    const int lo = t - R < 0 ? 0 : t - R, hi = t + R > SEQ - 1 ? SEQ - 1 : t + R;
    const float inv = 1.0f / (float)(hi - lo + 1);
    float xs[8]; UNPACK8(xs, w[R]);
    v4u ow; ow.x = pk2(acc[0] * inv - xs[0], acc[1] * inv - xs[1]); ow.y = pk2(acc[2] * inv - xs[2], acc[3] * inv - xs[3]);
    ow.z = pk2(acc[4] * inv - xs[4], acc[5] * inv - xs[5]); ow.w = pk2(acc[6] * inv - xs[6], acc[7] * inv - xs[7]);
    *(v4u*)mp = ow;
}
__device__ __forceinline__ void odd_pool(const bf16* proj, bf16* mix, int gw, int NGW, int lane) {
    for (int wi = gw; wi < M; wi += NGW) {
        const int g = wi & 3, tok = (wi >> 2) * 4 + (lane >> 4), c = g * 128 + (lane & 15) * 8, t = tok & (SEQ - 1);
        const bf16* pb = proj + (size_t)(tok - t) * OD_IN + c; bf16* mp = mix + (size_t)tok * 1024 + c;
        if (g == 0) pool_item<1>(pb, mp, t); else if (g == 1) pool_item<2>(pb, mp, t); else if (g == 2) pool_item<4>(pb, mp, t); else pool_item<8>(pb, mp, t);
    }
}

__device__ __forceinline__ void sgu_chunk(int ch, const bf16* proj, const bf16* sguw, const float* norm_g, const float* b_s, bf16* mix, LAS unsigned char* lds, int tid, int lane, int wave) {
    LAS float* rstd = (LAS float*)lds;
    LAS unsigned short* vnT = (LAS unsigned short*)(lds + 512);
    const size_t row0 = (size_t)ch * 128;
    const int q = tid >> 2, part = tid & 3, fr = lane & 15, fq = lane >> 4;
    { const bf16* vp = proj + (row0 + q) * OD_IN + 1024 + part * 128; float s = 0.f;
#pragma unroll 4
      for (int i = 0; i < 16; ++i) { const v4u w = *(const v4u*)(vp + 8 * i); float x[8]; UNPACK8(x, w);
#pragma unroll
          for (int e = 0; e < 8; ++e) { const float gl = gelu_tanh(x[e]); s += gl * gl; } }
      s += __shfl_xor(s, 1); s += __shfl_xor(s, 2);
      if (part == 0) rstd[q] = __builtin_amdgcn_rsqf(s * (1.0f / 512.0f) + EPS); }
    __syncthreads();
    for (int g = 0; g < 4; ++g) {
        { const float rs = rstd[q]; const int cs = part * 32; const bf16* vp = proj + (row0 + q) * OD_IN + 1024 + g * 128 + cs; const float* ng = norm_g + g * 128 + cs;
#pragma unroll
          for (int i = 0; i < 4; ++i) { const v4u w = *(const v4u*)(vp + 8 * i); float x[8]; UNPACK8(x, w);
              const f32x4 n0 = *(const f32x4*)(ng + 8 * i), n1 = *(const f32x4*)(ng + 8 * i + 4); const float nv[8] = {n0.x, n0.y, n0.z, n0.w, n1.x, n1.y, n1.z, n1.w};
#pragma unroll
              for (int e = 0; e < 8; ++e) vnT[(cs + 8 * i + e) * 136 + q] = (unsigned short)f2bf(gelu_tanh(x[e]) * rs * nv[e]); } }
        __syncthreads();
        f32x4 acc[8];
#pragma unroll
        for (int n = 0; n < 8; ++n) acc[n] = (f32x4){0.f, 0.f, 0.f, 0.f};
        const int p = 16 * wave + fr;
#pragma unroll
        for (int ks = 0; ks < 4; ++ks) { const bf16x8 af = *(const bf16x8*)(sguw + ((size_t)(g * 128 + p) * 128 + 32 * ks + 8 * fq));
#pragma unroll
            for (int n = 0; n < 8; ++n) { const bf16x8 bfv = *(const LAS bf16x8*)(vnT + (16 * n + fr) * 136 + 32 * ks + 8 * fq);
                acc[n] = __builtin_amdgcn_mfma_f32_16x16x32_bf16(bfv, af, acc[n], 0, 0, 0); } }
        const float bias = b_s[g * 128 + p];
        const bf16* up = proj + (row0 + p) * OD_IN + 512 + g * 128 + 4 * fq; bf16* op = mix + (row0 + p) * 1024 + 512 + g * 128 + 4 * fq;
#pragma unroll
        for (int n = 0; n < 8; ++n) { const v2u uw = *(const v2u*)(up + 16 * n);
            v2u ow; ow.x = pk2(gelu_tanh(bflo(uw.x)) * (acc[n][0] + bias), gelu_tanh(bfhi(uw.x)) * (acc[n][1] + bias)); ow.y = pk2(gelu_tanh(bflo(uw.y)) * (acc[n][2] + bias), gelu_tanh(bfhi(uw.y)) * (acc[n][3] + bias));
            *(v2u*)(op + 16 * n) = ow; }
        __syncthreads();
    }
}

struct Ctx { int tid, lane, wave, G, bx, vcu, gw, NGW, gtid, GT; };
__device__ __forceinline__ Ctx mkctx() {
    Ctx c; int t = threadIdx.x; asm volatile("" : "+v"(t)); int g = gridDim.x, b = blockIdx.x; asm volatile("" : "+s"(g), "+s"(b));
    c.tid = t; c.lane = t & 63; c.wave = __builtin_amdgcn_readfirstlane(t >> 6); c.G = g; c.bx = b;
    c.vcu = (g % 8 == 0) ? (b % 8) * (g / 8) + b / 8 : b;
    c.gw = c.vcu * NWAVES + c.wave; c.NGW = g * NWAVES; c.gtid = b * (NWAVES * 64) + t; c.GT = g * NWAVES * 64; return c;
}
__device__ __forceinline__ const Args* kargs() { auto p = __builtin_amdgcn_kernarg_segment_ptr(); asm volatile("" : "+s"(p)); return (const Args*)p; }
#define CG_SYNC() do { asm volatile("s_waitcnt vmcnt(0) lgkmcnt(0)" ::: "memory"); __syncthreads(); cg::this_grid().sync(); __builtin_amdgcn_fence(__ATOMIC_ACQUIRE, "agent"); asm volatile("s_waitcnt vmcnt(0)" ::: "memory"); } while (0)
#define GRID_SYNC() do { XcdBarrier b_; b_.bar = (unsigned*)(kargs()->ws + WS_BAR); b_.x = xb_xcc_id(); b_.st = (volatile LAS unsigned*)(lds + MISC_OFF); xcd_barrier(b_); } while (0)

__global__ void __launch_bounds__(NWAVES * 64, 2) mega_fwd(Args args_unused) {
    extern __shared__ __attribute__((aligned(16))) unsigned char lds_raw[];
    LAS unsigned char* lds = (LAS unsigned char*)lds_raw;
    if (threadIdx.x == 0) { ((volatile LAS unsigned*)(lds + MISC_OFF))[0] = 0u; ((volatile LAS unsigned*)(lds + MISC_OFF))[1] = 0u; }
    __syncthreads();
    (void)xcd_barrier_post((unsigned*)(kargs()->ws + WS_BAR), (volatile LAS unsigned*)(lds + MISC_OFF));
#ifndef DUP_P0
#define DUP_P0 0
#endif
    for (int rp = 0; rp <= DUP_P0; ++rp) { const Ctx c = mkctx(); const Args* A = kargs(); p0_prologue(*A, lds, c.gw, c.NGW, c.gtid, c.GT, c.wave, c.lane); }
    CG_SYNC();

    for (int j = 0; j < 12; ++j) {
        const int l = j / 3, kind = j - 3 * l;
        if (kind != 1) {
            const int wi = (kind == 2 ? 4 : 0) + l;
#ifndef DUP_G1
#define DUP_G1 0
#endif
            for (int rp = 0; rp <= DUP_G1; ++rp) { const Ctx c = mkctx(); const Args* A = kargs(); unsigned char* ws = A->ws;
              pg8::Gemm g{(const bf16*)(ws + WS_XB), (const bf16*)(ws + WS_W1T) + (size_t)wi * 5632 * 1024, M, 2 * DFF, DMODEL}; pg8::StaticOrder S; S.init(M, 2 * DFF, c.G, c.bx);
              pg8::EpiSwiGLU E{(bf16*)(ws + WS_ACT), DFF, (const float*)(ws + WS_SSQ) + (size_t)j * M * 4};
              pg8::gemm_phase<pg8::EpiSwiGLU, pg8::StaticOrder, true, true>(lds, g, S, E); }
            GRID_SYNC();
        } else {
            const int jj = l >> 1; const bool even = (l & 1) == 0;
#ifndef DUP_G3
#define DUP_G3 0
#endif
            for (int rp = 0; rp <= DUP_G3; ++rp) { const Ctx c = mkctx(); const Args* A = kargs(); unsigned char* ws = A->ws; const int N = even ? EV_IN : OD_IN;
              const bf16* wt = even ? (const bf16*)(ws + WS_EVIN) + (size_t)jj * EV_IN * 1024 : (const bf16*)(ws + WS_ODIN) + (size_t)jj * OD_IN * 1024;
              pg8::Gemm g{(const bf16*)(ws + WS_XB), wt, M, N, DMODEL}; pg8::StaticOrder S; S.init(M, N, c.G, c.bx);
              pg8::EpiRowScale E{(bf16*)(ws + WS_PROJ), N, (const float*)(ws + WS_SSQ) + (size_t)j * M * 4};
              pg8::gemm_phase<pg8::EpiRowScale, pg8::StaticOrder, true, true>(lds, g, S, E); }
            GRID_SYNC();
            if (even) {
                { const Ctx c = mkctx(); const Args* A = kargs(); unsigned char* ws = A->ws;
                  even_prep((bf16*)(ws + WS_PROJ), (bf16*)(ws + WS_MIX), A->in[I_EVQN] + jj * 64, A->in[I_EVKN] + jj * 64, A->in[I_EVCONV] + jj * 3 * 512, c.gtid, c.GT); }
                GRID_SYNC();
#ifndef DUP_ATTN
#define DUP_ATTN 0
#endif
                for (int rp = 0; rp <= DUP_ATTN; ++rp) { const Ctx c = mkctx(); const Args* A = kargs(); unsigned char* ws = A->ws; const attn_body::bf16* PROJ = (const attn_body::bf16*)(ws + WS_PROJ); attn_body::bf16* MIX = (attn_body::bf16*)(ws + WS_MIX);
                  for (int ui = c.vcu; ui < 1024; ui += c.G) {
                      const int bh = ui >> 3, qb = ui & 7, b = bh >> 3, h = bh & 7, kvh = h >> 2;
                      attn_body::attn_unit<8>(b, qb, PROJ + 1536 + h * 64, PROJ + 2048 + kvh * 64, PROJ + 2176 + kvh * 64, MIX + 512 + h * 64, (char*)lds_raw);
                  } }
            } else {
                { const Ctx c = mkctx(); const Args* A = kargs(); unsigned char* ws = A->ws; odd_pool((const bf16*)(ws + WS_PROJ), (bf16*)(ws + WS_MIX), c.gw, c.NGW, c.lane); }
#ifndef DUP_SGU
#define DUP_SGU 0
#endif
                for (int rp = 0; rp <= DUP_SGU; ++rp)
                { const Ctx c = mkctx(); const Args* A = kargs(); unsigned char* ws = A->ws;
                  for (int ch = c.vcu; ch < 256; ch += c.G)
                      sgu_chunk(ch, (const bf16*)(ws + WS_PROJ), (const bf16*)(ws + WS_SGUW) + (size_t)jj * 4 * 128 * 128, A->in[I_ODSN] + jj * 512, A->in[I_ODSB] + jj * 512, (bf16*)(ws + WS_MIX), lds, c.tid, c.lane, c.wave); }
            }
            GRID_SYNC();
        }
#ifndef DUP_G2
#define DUP_G2 0
#endif
        for (int rp = 0; rp <= DUP_G2; ++rp) { const Ctx c = mkctx(); const Args* A = kargs(); unsigned char* ws = A->ws; const bool ffn = kind != 1; const int jj = l >> 1;
          const bf16* wt = ffn ? (const bf16*)(ws + WS_W2T) + (size_t)((kind == 2 ? 4 : 0) + l) * 1024 * 2816 : ((l & 1) == 0 ? (const bf16*)(ws + WS_EVOUT) : (const bf16*)(ws + WS_ODOUT)) + (size_t)jj * 1024 * 1024;
          pg8::Gemm g{ffn ? (const bf16*)(ws + WS_ACT) : (const bf16*)(ws + WS_MIX), wt, M, DMODEL, ffn ? DFF : DMODEL}; pg8::StaticOrder S; S.init(M, DMODEL, c.G, c.bx);
          pg8::EpiResid E{(bf16*)(ws + WS_XB), (float*)(ws + WS_SSQ) + (size_t)(j + 1) * M * 4, rp < DUP_G2 ? 0.0f : (ffn ? 0.5f : 1.0f)};
          pg8::gemm_phase<pg8::EpiResid, pg8::StaticOrder, true, true>(lds, g, S, E); }
        GRID_SYNC();
#ifdef DUP_SYNC
        GRID_SYNC(); GRID_SYNC();
#endif
    }
    { const Ctx c = mkctx(); const Args* A = kargs(); float* out = A->out; const bf16* xb = (const bf16*)(A->ws + WS_XB); const float* ssq = (const float*)(A->ws + WS_SSQ) + (size_t)12 * M * 4; const f32x4* gf = (const f32x4*)A->in[I_FINN];
      for (int m = c.gw; m < M; m += c.NGW) { const float rs = pg8::row_rs(ssq, m); const v2u* xr = (const v2u*)(xb + (size_t)m * 1024) + c.lane; f32x4* orow = (f32x4*)(out + (size_t)m * 1024) + c.lane;
#pragma unroll
          for (int q = 0; q < 4; ++q) { const v2u w = xr[64 * q]; const f32x4 v = {bflo(w.x), bfhi(w.x), bflo(w.y), bfhi(w.y)}; orow[64 * q] = v * rs * gf[c.lane + 64 * q]; } } }
}

extern "C" void kernel_launch(void* const* d_in, const int* in_sizes, int n_in, void* d_out, int out_size, void* d_ws, size_t ws_size, hipStream_t stream) {
    static int grid = 0;
    if (grid == 0) {
        if (n_in != 21 || in_sizes[0] != M * DMODEL || out_size != M * DMODEL || ws_size < WS_END) { fprintf(stderr, "kernel_launch: unexpected shapes (n_in %d, in0 %d, out %d, ws %zu)\n", n_in, n_in > 0 ? in_sizes[0] : -1, out_size, ws_size); grid = -1; return; }
        int dev = 0, cus = 0, per_cu = 0;
        if (hipGetDevice(&dev) != hipSuccess || hipDeviceGetAttribute(&cus, hipDeviceAttributeMultiprocessorCount, dev) != hipSuccess) { grid = -1; return; }
        if (hipFuncSetAttribute((const void*)mega_fwd, hipFuncAttributeMaxDynamicSharedMemorySize, LDS_BYTES) != hipSuccess) { fprintf(stderr, "kernel_launch: hipFuncSetAttribute failed\n"); grid = -1; return; }
        if (hipOccupancyMaxActiveBlocksPerMultiprocessor(&per_cu, (const void*)mega_fwd, NWAVES * 64, LDS_BYTES) != hipSuccess || per_cu < 1) { fprintf(stderr, "kernel_launch: occupancy query says %d\n", per_cu); per_cu = 1; }
        (void)hipGetLastError();
        grid = cus * per_cu;
    }
    if (grid < 0) return;
    if (hipMemsetAsync((char*)d_ws + WS_BAR, 0, BAR_BYTES, stream) != hipSuccess) { fprintf(stderr, "kernel_launch: hipMemsetAsync failed\n"); return; }
    Args a{};
    for (int i = 0; i < 21; ++i) a.in[i] = (const float*)d_in[i];
    a.out = (float*)d_out; a.ws = (unsigned char*)d_ws;
    void* params[] = {&a};
    hipError_t e = hipLaunchCooperativeKernel((const void*)mega_fwd, dim3(grid), dim3(NWAVES * 64), params, LDS_BYTES, stream);
    if (e != hipSuccess) fprintf(stderr, "kernel_launch: cooperative launch failed: %s (grid %d)\n", hipGetErrorString(e), grid);
}
```

```cpp
#include <hip/hip_runtime.h>
#include <hip/hip_cooperative_groups.h>
#include <hip/hip_bf16.h>
#include <cstdio>
#include <cstdint>
#include <cmath>
namespace pg8 {
#define PG8_LAS __attribute__((address_space(3)))
typedef unsigned short bf16_t;
typedef short bf16x8 __attribute__((ext_vector_type(8)));
typedef float f32x4 __attribute__((ext_vector_type(4)));
typedef unsigned u32x4 __attribute__((ext_vector_type(4)));
constexpr int BM = 256, BK = 64, HALF = 128, HTB = HALF * BK * 2  , STAGE_BYTES = 8 * HTB, NXCD = 8, WGM = 8;

__host__ __device__ __forceinline__ int lds_byte(int r, int c) { const int st = (r >> 4) * 2 + (c >> 5), rr = r & 15, cc = c & 31, ob = rr * 64 + cc * 2; return st * 1024 + (ob ^ (((ob >> 9) & 1) << 5)); }
__host__ __device__ __forceinline__ void stage_rc(int b, int& R, int& C) { const int st = b / 1024, sb = b % 1024, swz = sb ^ (((sb >> 9) & 1) << 5); R = (st >> 1) * 16 + swz / 64; C = (st & 1) * 32 + (swz % 64) / 2; }
__host__ __device__ __forceinline__ int perm32(int rho) { const int n = rho >> 4, i = rho & 15; return 8 * (i >> 2) + 4 * n + (i & 3); }

struct Unit { int pm, pn; };
struct Gemm { const bf16_t* A; const bf16_t* Bt; int M, N, K; long xa; };

struct StaticOrder {
    int nM, nN, nwg, G, c;
    __host__ __device__ void init(int M, int N, int G_, int c_) { nM = M / BM; nN = N / BM; nwg = nM * nN; G = G_; c = c_; }
    __host__ __device__ bool next(int i, Unit& u) const {
        const long L = (long)i * G + c; if (L >= nwg) return false;
        int wgid = (int)L; { const int q = nwg / NXCD, r = nwg % NXCD, xcd = wgid % NXCD, off = wgid / NXCD; wgid = (xcd < r ? xcd * (q + 1) : r * (q + 1) + (xcd - r) * q) + off; }
        const int nig = WGM * nN, gid = wgid / nig, fm = gid * WGM, gsz = (nM - fm) < WGM ? (nM - fm) : WGM;
        u.pm = fm + ((wgid % nig) % gsz); u.pn = (wgid % nig) / gsz; return true;
    }
    __device__ __forceinline__ void a_ready(const Unit&) const {}
    __device__ __forceinline__ void done(const Unit&) const {}
};
__device__ __forceinline__ unsigned cvt_pk_bf16(float lo, float hi) { unsigned r; asm volatile("v_cvt_pk_bf16_f32 %0, %1, %2" : "=v"(r) : "v"(lo), "v"(hi)); return r; }
typedef float f32x2 __attribute__((ext_vector_type(2)));
__device__ __forceinline__ float row_rs(const float* ssq, int row) { const f32x4 p = *(const f32x4*)(ssq + 4 * (size_t)row); return __builtin_amdgcn_rsqf(((p[0] + p[1]) + (p[2] + p[3])) * (1.0f / 1024.0f) + 1e-6f); }
typedef float f32x2 __attribute__((ext_vector_type(2)));
__device__ __forceinline__ f32x2 swiglu2(f32x2 g, f32x2 u, float nl, float rs2) {
    f32x2 t = g * nl; t.x = __builtin_fminf(t.x, 60.0f); t.y = __builtin_fminf(t.y, 60.0f);
    f32x2 d; d.x = __builtin_amdgcn_exp2f(t.x); d.y = __builtin_amdgcn_exp2f(t.y); d = d + 1.0f;
    const float r = __builtin_amdgcn_rcpf(d.x * d.y);
    const f32x2 ri = (f32x2){d.y, d.x} * r;
    return (g * u) * (ri * rs2);
}
struct EpiSwiGLU {
    static constexpr bool PERM = true, AFTER_DRAIN = false;
    bf16_t* O_; int ldc; const float* ssq; long xo;
    __device__ __forceinline__ void operator()(const f32x4 (&acc)[2][2][4][2], const Unit& u, int wr, int wc, int fr, int fq) const {
        bf16_t* O = O_ + (long)(u.pm >> 4) * xo;
        const int row0 = u.pm * BM + wr * 64 + fr, col0 = u.pn * HALF + wc * 32 + 8 * fq;
        float rsv[2][4];
#pragma unroll
        for (int ai = 0; ai < 2; ++ai)
#pragma unroll
            for (int m = 0; m < 4; ++m) rsv[ai][m] = row_rs(ssq, row0 + ai * HALF + m * 16);
#pragma unroll
        for (int ai = 0; ai < 2; ++ai)
#pragma unroll
            for (int m = 0; m < 4; ++m) { const int row = row0 + ai * HALF + m * 16; const float rs = rsv[ai][m], nl = -1.4426950408889634f * rs, rs2 = rs * rs;
                const f32x4 g0 = acc[ai][0][m][0], g1 = acc[ai][0][m][1], u0 = acc[ai][1][m][0], u1 = acc[ai][1][m][1];
                const f32x2 a = swiglu2((f32x2){g0[0], g0[1]}, (f32x2){u0[0], u0[1]}, nl, rs2), b = swiglu2((f32x2){g0[2], g0[3]}, (f32x2){u0[2], u0[3]}, nl, rs2);
                const f32x2 c = swiglu2((f32x2){g1[0], g1[1]}, (f32x2){u1[0], u1[1]}, nl, rs2), d = swiglu2((f32x2){g1[2], g1[3]}, (f32x2){u1[2], u1[3]}, nl, rs2);
                u32x4 w; w.x = cvt_pk_bf16(a.x, a.y); w.y = cvt_pk_bf16(b.x, b.y); w.z = cvt_pk_bf16(c.x, c.y); w.w = cvt_pk_bf16(d.x, d.y);
                *(u32x4*)(O + (size_t)row * ldc + col0) = w; }
    }
};
struct EpiRowScale {
    static constexpr bool PERM = true, AFTER_DRAIN = false;
    bf16_t* O_; int ldc; const float* ssq; long xo;
    __device__ __forceinline__ void operator()(const f32x4 (&acc)[2][2][4][2], const Unit& u, int wr, int wc, int fr, int fq) const {
        bf16_t* O = O_ + (long)(u.pm >> 4) * xo;
        const int row0 = u.pm * BM + wr * 64 + fr, col0 = u.pn * BM + wc * 32 + 8 * fq;
#pragma unroll
        for (int ai = 0; ai < 2; ++ai)
#pragma unroll
            for (int m = 0; m < 4; ++m) { const int row = row0 + ai * HALF + m * 16; const float rs = row_rs(ssq, row); bf16_t* rowp = O + (size_t)row * ldc + col0;
#pragma unroll
                for (int bj = 0; bj < 2; ++bj) { const f32x4 v0 = acc[ai][bj][m][0] * rs, v1 = acc[ai][bj][m][1] * rs;
                    u32x4 w; w.x = cvt_pk_bf16(v0[0], v0[1]); w.y = cvt_pk_bf16(v0[2], v0[3]); w.z = cvt_pk_bf16(v1[0], v1[1]); w.w = cvt_pk_bf16(v1[2], v1[3]);
                    *(u32x4*)(rowp + bj * HALF) = w; } }
    }
};
struct EpiResid {
    static constexpr bool PERM = true, AFTER_DRAIN = false;
    bf16_t* xb; float* ssq_out; float alpha;
    __device__ __forceinline__ void operator()(const f32x4 (&acc)[2][2][4][2], const Unit& u, int wr, int wc, int fr, int fq) const {
        PG8_LAS float* P = (PG8_LAS float*)(STAGE_BYTES);
        const int row0 = u.pm * BM + wr * 64 + fr, col0 = u.pn * BM + wc * 32 + 8 * fq;
#pragma unroll
        for (int ai = 0; ai < 2; ++ai)
#pragma unroll
            for (int m = 0; m < 4; ++m) { const int row = row0 + ai * HALF + m * 16; bf16_t* rowp = xb + (size_t)row * 1024 + col0; float s = 0.f;
#pragma unroll
                for (int bj = 0; bj < 2; ++bj) { const u32x4 b = *(const u32x4*)(rowp + bj * HALF);
                    const f32x4 b0 = {__builtin_bit_cast(float, b.x << 16), __builtin_bit_cast(float, b.x & 0xffff0000u), __builtin_bit_cast(float, b.y << 16), __builtin_bit_cast(float, b.y & 0xffff0000u)};
                    const f32x4 b1 = {__builtin_bit_cast(float, b.z << 16), __builtin_bit_cast(float, b.z & 0xffff0000u), __builtin_bit_cast(float, b.w << 16), __builtin_bit_cast(float, b.w & 0xffff0000u)};
                    const f32x4 o0 = b0 + acc[ai][bj][m][0] * alpha, o1 = b1 + acc[ai][bj][m][1] * alpha;
                    s += ((o0[0] * o0[0] + o0[1] * o0[1]) + (o0[2] * o0[2] + o0[3] * o0[3])) + ((o1[0] * o1[0] + o1[1] * o1[1]) + (o1[2] * o1[2] + o1[3] * o1[3]));
                    u32x4 w; w.x = cvt_pk_bf16(o0[0], o0[1]); w.y = cvt_pk_bf16(o0[2], o0[3]); w.z = cvt_pk_bf16(o1[0], o1[1]); w.w = cvt_pk_bf16(o1[2], o1[3]);
                    *(u32x4*)(rowp + bj * HALF) = w; }
                s += __shfl_xor(s, 16); s += __shfl_xor(s, 32);
                if (fq == 0) P[(ai * HALF + wr * 64 + m * 16 + fr) * 4 + wc] = s;
                if (m & 1) asm volatile("" ::: "memory"); }
        asm volatile("s_waitcnt lgkmcnt(0)" ::: "memory"); __builtin_amdgcn_s_barrier(); asm volatile("" ::: "memory");
        int t = threadIdx.x; asm volatile("" : "+v"(t));
        if (t < 256) { const f32x4 p = *(const PG8_LAS f32x4*)(P + 4 * t); ssq_out[(size_t)(u.pm * BM + t) * 4 + u.pn] = (p[0] + p[1]) + (p[2] + p[3]); }
    }
};

template <class Epi, class Sched, bool ALIGN_EPI = false, bool SP2 = false>
__device__ __forceinline__ void gemm_phase(PG8_LAS unsigned char* lds, const Gemm g, const Sched& S, const Epi& E) {
    int tid_ = threadIdx.x; asm volatile("" : "+v"(tid_));
    const int tid = tid_, wid = __builtin_amdgcn_readfirstlane(tid >> 6), lane = tid & 63, wr = wid >> 2, wc = wid & 3, fr = lane & 15, fq = lane >> 4;
    const int K = g.K, nt = K / BK;
    unsigned voffA[2], voffB[2];
#pragma unroll
    for (int i = 0; i < 2; ++i) { int R, C; stage_rc(tid * 16 + i * 8192, R, C); const int Rb = Epi::PERM ? ((R & ~31) + perm32(R & 31)) : R;
        voffA[i] = (unsigned)(R * K + C) * 2u; voffB[i] = (unsigned)(Rb * K + C) * 2u; }
    const size_t kstep = (size_t)(BK * 2);
    const size_t hstep = (size_t)HALF * K * 2;
    const size_t tstep = 2 * hstep;
    const unsigned ldsw = (unsigned)wid * 1024u;
    const int aoff = lds_byte(wr * 64 + fr, fq * 8), boff = lds_byte(wc * 32 + fr, fq * 8);
#define PG8_SA(b, h) (((b) * 2 + (h)) * HTB)
#define PG8_SB(b, h) ((4 + (b) * 2 + (h)) * HTB)
#define PG8_STAGE(bufoff, gbase, voff) do { _Pragma("unroll") for (int _i = 0; _i < 2; ++_i) \
        __builtin_amdgcn_global_load_lds((const unsigned*)((const char*)(gbase) + (voff)[_i]), (PG8_LAS unsigned*)(lds + (bufoff) + ldsw + _i * 8192), 16, 0, 0); } while (0)
#define PG8_LDA(dst, b, h) do { _Pragma("unroll") for (int m = 0; m < 4; ++m) _Pragma("unroll") for (int k = 0; k < 2; ++k) dst[m][k] = *(const PG8_LAS bf16x8*)(lds + PG8_SA(b, h) + aoff + m * 2048 + k * 1024); } while (0)
#define PG8_LDB(dst, b, h) do { _Pragma("unroll") for (int n = 0; n < 2; ++n) _Pragma("unroll") for (int k = 0; k < 2; ++k) dst[n][k] = *(const PG8_LAS bf16x8*)(lds + PG8_SB(b, h) + boff + n * 2048 + k * 1024); } while (0)
#define PG8_MMA(ai, bj, At, Bt) do { __builtin_amdgcn_s_setprio(1); _Pragma("unroll") for (int m = 0; m < 4; ++m) _Pragma("unroll") for (int n = 0; n < 2; ++n) _Pragma("unroll") for (int k = 0; k < 2; ++k) \
        acc[ai][bj][m][n] = __builtin_amdgcn_mfma_f32_16x16x32_bf16(Bt[n][k], At[m][k], acc[ai][bj][m][n], 0, 0, 0); __builtin_amdgcn_s_setprio(0); } while (0)
#define PG8_WAIT_V(n) asm volatile("s_waitcnt vmcnt(" #n ")" ::: "memory")
#define PG8_WAIT_L(n) asm volatile("s_waitcnt lgkmcnt(" #n ")" ::: "memory")
#define PG8_BAR __builtin_amdgcn_s_barrier()
#define PG8_SCHED __builtin_amdgcn_sched_barrier(0)
    Unit cur, nxt; int ui = 0;
    if (!S.next(0, cur)) return;
    f32x4 acc[2][2][4][2];
#pragma unroll
    for (int a = 0; a < 2; ++a)
#pragma unroll
        for (int b = 0; b < 2; ++b)
#pragma unroll
            for (int m = 0; m < 4; ++m)
#pragma unroll
                for (int n = 0; n < 2; ++n) acc[a][b][m][n] = (f32x4){0.f, 0.f, 0.f, 0.f};
    bf16x8 At[4][2], B0[2][2], B1[2][2];
    const char* cA = (const char*)g.A + (size_t)cur.pm * tstep + (long)(cur.pm >> 4) * g.xa; const char* cB = (const char*)g.Bt + (size_t)cur.pn * tstep;
    S.a_ready(cur);
    if constexpr (SP2) {
        PG8_STAGE(PG8_SB(0, 0), cB, voffB); PG8_STAGE(PG8_SB(0, 1), cB + hstep, voffB); PG8_STAGE(PG8_SA(0, 0), cA, voffA); PG8_STAGE(PG8_SA(0, 1), cA + hstep, voffA);
        if (wr == 1) PG8_BAR;
        PG8_WAIT_V(2); PG8_BAR;
        PG8_STAGE(PG8_SB(1, 0), cB + kstep, voffB); PG8_STAGE(PG8_SA(1, 0), cA + kstep, voffA); PG8_STAGE(PG8_SB(1, 1), cB + hstep + kstep, voffB);
        PG8_WAIT_V(6); PG8_BAR;
    } else {
        PG8_STAGE(PG8_SB(0, 0), cB, voffB); PG8_STAGE(PG8_SA(0, 0), cA, voffA); PG8_STAGE(PG8_SB(0, 1), cB + hstep, voffB); PG8_STAGE(PG8_SA(0, 1), cA + hstep, voffA);
        if (wr == 1) PG8_BAR;
        PG8_WAIT_V(4); PG8_BAR;
        PG8_STAGE(PG8_SB(1, 0), cB + kstep, voffB); PG8_STAGE(PG8_SA(1, 0), cA + kstep, voffA); PG8_STAGE(PG8_SB(1, 1), cB + hstep + kstep, voffB);
        PG8_WAIT_V(6); PG8_BAR;
    }
    for (;;) {
        const bool has_next = S.next(ui + 1, nxt);
        const char* nA = has_next ? (const char*)g.A + (size_t)nxt.pm * tstep + (long)(nxt.pm >> 4) * g.xa : cA; const char* nB = has_next ? (const char*)g.Bt + (size_t)nxt.pn * tstep : cB;
        for (int t = 0; t < nt; t += 2) {
            const bool last = (t == nt - 2);
            const char* a1 = cA + (size_t)(t + 1) * kstep;
            const char* a2 = last ? nA : cA + (size_t)(t + 2) * kstep; const char* b2 = last ? nB : cB + (size_t)(t + 2) * kstep;
            const char* a3 = a2 + kstep; const char* b3 = b2 + kstep;
            if (last && has_next) S.a_ready(nxt);
            if constexpr (SP2) {
            PG8_LDB(B0, 0, 0); PG8_LDB(B1, 0, 1); PG8_SCHED; PG8_LDA(At, 0, 0); PG8_STAGE(PG8_SA(1, 1), a1 + hstep, voffA);
            PG8_WAIT_V(8); PG8_WAIT_L(0); PG8_BAR; PG8_MMA(0, 0, At, B0); PG8_MMA(0, 1, At, B1); PG8_BAR; PG8_SCHED;
            PG8_LDA(At, 0, 1); PG8_STAGE(PG8_SB(0, 0), b2, voffB); PG8_STAGE(PG8_SB(0, 1), b2 + hstep, voffB); PG8_STAGE(PG8_SA(0, 0), a2, voffA);
            PG8_WAIT_V(8); PG8_WAIT_L(0); PG8_BAR; PG8_MMA(1, 0, At, B0); PG8_MMA(1, 1, At, B1); PG8_BAR; PG8_SCHED;
            PG8_LDB(B0, 1, 0); PG8_LDB(B1, 1, 1); PG8_SCHED; PG8_LDA(At, 1, 0); PG8_STAGE(PG8_SA(0, 1), a2 + hstep, voffA);
            PG8_WAIT_V(8); PG8_WAIT_L(0); PG8_BAR; PG8_MMA(0, 0, At, B0); PG8_MMA(0, 1, At, B1); PG8_BAR; PG8_SCHED;
            PG8_LDA(At, 1, 1); PG8_STAGE(PG8_SB(1, 0), b3, voffB); PG8_STAGE(PG8_SB(1, 1), b3 + hstep, voffB); PG8_STAGE(PG8_SA(1, 0), a3, voffA);
            PG8_WAIT_V(8); PG8_WAIT_L(0); PG8_BAR; PG8_MMA(1, 0, At, B0); PG8_MMA(1, 1, At, B1); PG8_BAR; PG8_SCHED;
            } else {
            PG8_LDB(B0, 0, 0); PG8_SCHED; PG8_LDA(At, 0, 0); PG8_STAGE(PG8_SA(1, 1), a1 + hstep, voffA);
            PG8_WAIT_L(8); PG8_BAR; PG8_WAIT_L(0); PG8_MMA(0, 0, At, B0); PG8_BAR; PG8_SCHED;
            PG8_LDB(B1, 0, 1); PG8_STAGE(PG8_SB(0, 0), b2, voffB);
            PG8_BAR; PG8_WAIT_L(0); PG8_MMA(0, 1, At, B1); PG8_BAR;
            PG8_LDA(At, 0, 1); PG8_STAGE(PG8_SA(0, 0), a2, voffA);
            PG8_BAR; PG8_WAIT_L(0); PG8_MMA(1, 0, At, B0); PG8_BAR; PG8_SCHED;
            PG8_STAGE(PG8_SB(0, 1), b2 + hstep, voffB);
            PG8_WAIT_V(6); PG8_BAR; PG8_MMA(1, 1, At, B1); PG8_BAR;
            PG8_LDB(B0, 1, 0); PG8_SCHED; PG8_LDA(At, 1, 0); PG8_STAGE(PG8_SA(0, 1), a2 + hstep, voffA);
            PG8_WAIT_L(8); PG8_BAR; PG8_WAIT_L(0); PG8_MMA(0, 0, At, B0); PG8_BAR; PG8_SCHED;
            PG8_LDB(B1, 1, 1); PG8_STAGE(PG8_SB(1, 0), b3, voffB);
            PG8_BAR; PG8_WAIT_L(0); PG8_MMA(0, 1, At, B1); PG8_BAR;
            PG8_LDA(At, 1, 1); PG8_STAGE(PG8_SA(1, 0), a3, voffA);
            PG8_BAR; PG8_WAIT_L(0); PG8_MMA(1, 0, At, B0); PG8_BAR; PG8_SCHED;
            PG8_STAGE(PG8_SB(1, 1), b3 + hstep, voffB);
            PG8_WAIT_V(6); PG8_BAR; PG8_MMA(1, 1, At, B1); PG8_BAR;
            }
        }
        if constexpr (ALIGN_EPI) { if (wr == 0) PG8_BAR; }
        if constexpr (!Epi::AFTER_DRAIN) { E(acc, cur, wr, wc, fr, fq); S.done(cur); }
        if (!has_next) break;
#pragma unroll
        for (int a = 0; a < 2; ++a)
#pragma unroll
            for (int b = 0; b < 2; ++b)
#pragma unroll
                for (int m = 0; m < 4; ++m)
#pragma unroll
                    for (int n = 0; n < 2; ++n) acc[a][b][m][n] = (f32x4){0.f, 0.f, 0.f, 0.f};
        cur = nxt; cA = nA; cB = nB; ++ui;
        if constexpr (ALIGN_EPI) { if (wr == 1) PG8_BAR; }
    }
    PG8_WAIT_V(0);
    if constexpr (!ALIGN_EPI) { if (wr == 0) PG8_BAR; }
    PG8_BAR;
    if constexpr (Epi::AFTER_DRAIN) { E.fused(acc, cur, wr, wc, fr, fq, lds, wid, lane); S.done(cur); }
#undef PG8_SA
#undef PG8_SB
#undef PG8_STAGE
#undef PG8_LDA
#undef PG8_LDB
#undef PG8_MMA
#undef PG8_WAIT_V
#undef PG8_WAIT_L
#undef PG8_BAR
#undef PG8_SCHED
}
}
namespace attn_body {
using bf16=__hip_bfloat16;
using bf16x8=__attribute__((ext_vector_type(8)))short;
using s16x4=__attribute__((ext_vector_type(4)))short;
using f32x16=__attribute__((ext_vector_type(16)))float;
using u32x4=__attribute__((ext_vector_type(4)))unsigned;
constexpr int BATCH=16,NHEAD=8,SEQ=2048,D=64,PQ=2304,PO=1024;
constexpr int NW=8,QBLK=32,QB=QBLK*NW,KVBLK=64,NQB=SEQ/QB;
constexpr int ATTN_UNIT_ROWS=QB;
__device__ __forceinline__ int crow(int r,int hi){return (r&3)+8*(r>>2)+4*hi;}
#define SBAR() __builtin_amdgcn_sched_barrier(0)
__device__ __forceinline__ void cmask(f32x16&p0,f32x16&p1,int jb,int qrel,int hi){
  const float NEG=-INFINITY; int kb=64*jb+4*hi;
  #pragma unroll
  for(int r=0;r<16;++r){int kv=kb+(r&3)+8*(r>>2); if(kv>qrel)p0[r]=NEG; if(kv+32>qrel)p1[r]=NEG;}
}

constexpr int NSLOT=3, SLOTB=8192;
constexpr int LDS_K=0, LDS_V=NSLOT*SLOTB, LDS_WS=2*NSLOT*SLOTB, LDS_OST=LDS_WS+NW*64*4, LDS_BYTES=LDS_OST+NW*4096;
constexpr float C2=0.125f*1.4426950408889634f;
__device__ __forceinline__ void glds16(const void*gsrc,unsigned lds_dst){unsigned keep;
  asm volatile("s_mov_b32 %0, m0\n\ts_mov_b32 m0, %2\n\ts_nop 0\n\tglobal_load_lds_dwordx4 %1, off\n\ts_mov_b32 m0, %0":"=&s"(keep):"v"(gsrc),"s"(lds_dst):"memory");}
__device__ __forceinline__ float max3f(float a,float b,float c){float r;asm("v_max3_f32 %0, %1, %2, %3":"=v"(r):"v"(a),"v"(b),"v"(c));return r;}
__device__ __forceinline__ float max2f(float a,float b){float r;asm("v_max_f32_e32 %0, %1, %2":"=v"(r):"v"(a),"v"(b));return r;}
__device__ __forceinline__ float fadd_s(float a,float b){float r;asm("v_add_f32_e32 %0, %1, %2":"=v"(r):"v"(a),"v"(b));return r;}
__device__ __forceinline__ float fsub_s(float a,float b){float r;asm("v_sub_f32_e32 %0, %1, %2":"=v"(r):"v"(a),"v"(b));return r;}
typedef float f32x2_t __attribute__((ext_vector_type(2))); typedef __bf16 bf16x2_t __attribute__((ext_vector_type(2)));
__device__ __forceinline__ unsigned cvtpk_s(float lo,float hi){f32x2_t v={lo,hi};bf16x2_t b=__builtin_convertvector(v,bf16x2_t);return __builtin_bit_cast(unsigned,b);}
#define WAIT_BAR(N) asm volatile("s_waitcnt vmcnt(" #N ") lgkmcnt(0)\n\ts_barrier":::"memory")

__device__ __forceinline__ void qkt(f32x16&p0,f32x16&p1,const char*Kslot,const bf16x8*qr,const f32x16&negm,int r32,int hi){
  const char*kb=Kslot+hi*1024+r32*16;
  #pragma unroll
  for(int d0=0;d0<4;++d0){
    const bf16x8 b0=*reinterpret_cast<const bf16x8*>(kb+d0*2048);
    const bf16x8 b1=*reinterpret_cast<const bf16x8*>(kb+d0*2048+512);
    if(d0==0){p0=__builtin_amdgcn_mfma_f32_32x32x16_bf16(b0,qr[0],negm,0,0,0);p1=__builtin_amdgcn_mfma_f32_32x32x16_bf16(b1,qr[0],negm,0,0,0);}
    else{p0=__builtin_amdgcn_mfma_f32_32x32x16_bf16(b0,qr[d0],p0,0,0,0);p1=__builtin_amdgcn_mfma_f32_32x32x16_bf16(b1,qr[d0],p1,0,0,0);}}
}
typedef __attribute__((address_space(3))) const char* lds_cptr;
typedef short v4i16_t __attribute__((ext_vector_type(4)));
__device__ __forceinline__ void kload8(bf16x8*kf,lds_cptr kp){
  kf[0]=*(const __attribute__((address_space(3))) bf16x8*)(kp);      kf[1]=*(const __attribute__((address_space(3))) bf16x8*)(kp+512);
  kf[2]=*(const __attribute__((address_space(3))) bf16x8*)(kp+2048); kf[3]=*(const __attribute__((address_space(3))) bf16x8*)(kp+2560);
  kf[4]=*(const __attribute__((address_space(3))) bf16x8*)(kp+4096); kf[5]=*(const __attribute__((address_space(3))) bf16x8*)(kp+4608);
  kf[6]=*(const __attribute__((address_space(3))) bf16x8*)(kp+6144); kf[7]=*(const __attribute__((address_space(3))) bf16x8*)(kp+6656);
}
__device__ __forceinline__ void kload2(bf16x8*kf,lds_cptr kp,int j){ kf[2*j]=*(const __attribute__((address_space(3))) bf16x8*)(kp+j*2048); kf[2*j+1]=*(const __attribute__((address_space(3))) bf16x8*)(kp+j*2048+512); }
__device__ __forceinline__ s16x4 vtr(lds_cptr p){ return __builtin_bit_cast(s16x4,__builtin_amdgcn_ds_read_tr16_b64_v4i16((__attribute__((address_space(3))) v4i16_t*)p)); }
__device__ __forceinline__ float rowmax(const f32x16&p0,const f32x16&p1){
  float a=max3f(p0[0],p0[1],p1[0]),b=max3f(p0[2],p0[3],p1[1]);a=max3f(a,p1[2],p1[3]);
  #pragma unroll
  for(int r=4;r<16;r+=4){a=max3f(a,p0[r],p0[r+1]);b=max3f(b,p0[r+2],p0[r+3]);a=max3f(a,p1[r],p1[r+1]);b=max3f(b,p1[r+2],p1[r+3]);}
  const float m=max2f(a,b);
  auto rr=__builtin_amdgcn_permlane32_swap(__float_as_uint(m),__float_as_uint(m),false,false);
  return max2f(__uint_as_float(rr[0]),__uint_as_float(rr[1]));
}
__device__ __forceinline__ void pv(f32x16*o,int vb,bf16x8 pa0,bf16x8 pa1,bf16x8 pa2,bf16x8 pa3){
  #pragma unroll
  for(int d0=0;d0<2;++d0){s16x4 lo[4],hi[4];
    #pragma unroll
    for(int ks=0;ks<4;++ks){
      asm volatile("ds_read_b64_tr_b16 %0,%1 offset:%c2":"=&v"(lo[ks]):"v"(vb),"i"(d0*4096+ks*1024):"memory");
      asm volatile("ds_read_b64_tr_b16 %0,%1 offset:%c2":"=&v"(hi[ks]):"v"(vb),"i"(d0*4096+ks*1024+512):"memory");}
    asm volatile("s_waitcnt lgkmcnt(0)":::"memory");SBAR();
    #define PK(k) (bf16x8){lo[k][0],lo[k][1],lo[k][2],lo[k][3],hi[k][0],hi[k][1],hi[k][2],hi[k][3]}
    o[d0]=__builtin_amdgcn_mfma_f32_32x32x16_bf16(pa0,PK(0),o[d0],0,0,0);
    o[d0]=__builtin_amdgcn_mfma_f32_32x32x16_bf16(pa1,PK(1),o[d0],0,0,0);
    o[d0]=__builtin_amdgcn_mfma_f32_32x32x16_bf16(pa2,PK(2),o[d0],0,0,0);
    o[d0]=__builtin_amdgcn_mfma_f32_32x32x16_bf16(pa3,PK(3),o[d0],0,0,0);
    #undef PK
  }
}

#ifndef ATTN_STORE16
#define ATTN_STORE16(p,v) (*(u32x4*)(p)=(v))
#endif
template<int THRL> __device__ __forceinline__ void attn_unit(int b,int qb,const bf16*Q,const bf16*__restrict__ K,const bf16*__restrict__ V,bf16*O,char*shm){
  int tid_=threadIdx.x; asm volatile("":"+v"(tid_)); const int tid=tid_,lane=tid&63,r32=lane&31,hi=lane>>5; const int wid=__builtin_amdgcn_readfirstlane(tid>>6);
  const long rowbase=(long)b*SEQ; const int q0=qb*QB;
  const bf16*Qw=Q+(rowbase+q0+wid*QBLK)*PQ;
  const bf16*Kh=K+rowbase*PQ,*Vh=V+rowbase*PQ;
  const unsigned lds0=(unsigned)(uintptr_t)shm;
  float*wsf=(float*)(shm+LDS_WS)+wid*64;
  const bf16*ksrc=Kh+(long)lane*PQ+wid*8;
  const bf16*vsrc=Vh+(long)(16*(wid&3)+(lane>>2))*PQ+(wid>>2)*32+(lane&3)*8;
  const unsigned kdst=lds0+LDS_K+wid*1024, vdst=lds0+LDS_V+wid*1024;
  #define DMA_K(t,slot) glds16(ksrc+(long)(t)*KVBLK*PQ,(unsigned)__builtin_amdgcn_readfirstlane(kdst+(slot)))
  #define DMA_V(t,slot) glds16(vsrc+(long)(t)*KVBLK*PQ,(unsigned)__builtin_amdgcn_readfirstlane(vdst+(slot)))
  const int vb0=(int)(lds0+LDS_V)+((lane>>4)&1)*32+(lane&3)*8+(4*hi+((lane&15)>>2))*64;
  const char*Kbase=shm+LDS_K; bf16x8 kf[8];
  const lds_cptr shm3=(lds_cptr)shm; const lds_cptr kp0=shm3+LDS_K+hi*1024+r32*16; const lds_cptr vp0=shm3+LDS_V+((lane>>4)&1)*32+(lane&3)*8+(4*hi+((lane&15)>>2))*64;
  int NT=SEQ/KVBLK; asm volatile("":"+s"(NT));
  DMA_K(0,0);DMA_V(0,0);DMA_K(1,SLOTB);
  bf16x8 qr[4];
  #pragma unroll
  for(int d0=0;d0<4;++d0)qr[d0]=*reinterpret_cast<const bf16x8*>(&Qw[(long)r32*PQ+d0*16+hi*8]);
  float mhat=0.f,l_reg=0.f;f32x16 o[2];o[0]=f32x16{};o[1]=f32x16{};f32x16 negm=f32x16{};asm volatile("":"+v"(negm));
    #define CMASK(P0,P1,t) do{}while(0)
  bool resc=false;
  #define START(P0,P1) do{ const float rm=rowmax(P0,P1); resc=false; \
    { const float dl=rm; mhat=fadd_s(mhat,dl); \
      _Pragma("unroll") for(int r=0;r<16;++r){P0[r]=fsub_s(P0[r],dl);P1[r]=fsub_s(P1[r],dl);} \
      _Pragma("unroll") for(int r=0;r<16;++r)negm[r]=-mhat; asm volatile("":"+v"(negm)); } \
    _Pragma("unroll") for(int r=0;r<16;++r)P0[r]=__builtin_amdgcn_exp2f(P0[r]); }while(0)
  #define RESC() do{ if(resc){ asm volatile("s_waitcnt lgkmcnt(0)":::"memory"); \
      _Pragma("unroll") for(int d_=0;d_<2;++d_) _Pragma("unroll") for(int r=0;r<16;++r)o[d_][r]*=wsf[crow(r,hi)]; } }while(0)
  f32x16 pA0,pA1,pB0,pB1;
  int sl_prev=0,sl_cur=0,sl_next=SLOTB;
  #define ROT() do{sl_prev=sl_cur;sl_cur=sl_next;sl_next=(sl_next==(NSLOT-1)*SLOTB)?0:sl_next+SLOTB;}while(0)
  DMA_K(2,2*SLOTB);
  WAIT_BAR(3);
  qkt(pA0,pA1,Kbase,qr,negm,r32,hi);asm volatile("s_nop 15\n\ts_nop 7":"+v"(pA0),"+v"(pA1));CMASK(pA0,pA1,0);
  START(pA0,pA1);
  _Pragma("unroll") for(int r=0;r<16;++r)pA1[r]=__builtin_amdgcn_exp2f(pA1[r]);
  WAIT_BAR(0);
  DMA_K(3,0);DMA_V(1,SLOTB);
  ROT();
  kload8(kf,kp0+sl_cur);
  WAIT_BAR(2);
  s16x4 vlo[8],vhi[8]; u32x4 pw0,pw1,pw2,pw3;
  #define PKW(P,B) cvtpk_s(P[B],P[B+1])
  #define PAF(k) __builtin_bit_cast(bf16x8,pw##k)
  #define VFR(i) (bf16x8){vlo[i][0],vlo[i][1],vlo[i][2],vlo[i][3],vhi[i][0],vhi[i][1],vhi[i][2],vhi[i][3]}
  #define PIN(x) asm volatile("":"+v"(x))
  #define MX3(a,b,c) __builtin_fmaxf(__builtin_fmaxf((a),(b)),(c))
  #define GAPA(MF,A0,A1,A2,A3,W0,W1,PW) do{ MF; sacc+=A0; sacc+=A1; sacc+=A2; sacc+=A3; PIN(sacc); W0; W1; PIN(PW); SBAR(); }while(0)
  #define EX(v) __builtin_amdgcn_exp2f(v)
  #define GAPB(MF,X,B) do{ MF; X[B]=EX(X[B]); X[B+1]=EX(X[B+1]); X[B+2]=EX(X[B+2]); X[B+3]=EX(X[B+3]); PIN(X); SBAR(); }while(0)
  #define VRD(i) do{ vlo[i]=vtr(vp_+(((i)>>2)*4096+((i)&3)*1024)); vhi[i]=vtr(vp_+(((i)>>2)*4096+((i)&3)*1024+512)); }while(0)
  #define KRD(G,j) do{ if(G){ kload2(kf,kp0+sl_next,j); SBAR(); } }while(0)
  #define STEP(C0,C1,P0,P1,t,GK,GV,GL) do{ SBAR(); \
    const lds_cptr vp_=vp0+sl_prev; \
    VRD(0); SBAR(); float sacc=(P0[0]+P0[1]); \
    GAPA(C0=__builtin_amdgcn_mfma_f32_32x32x16_bf16(kf[0],qr[0],negm,0,0,0), P0[2],P0[3],P0[4],P0[5],     pw0[0]=PKW(P0,0), pw0[1]=PKW(P0,2), pw0); \
    VRD(4); SBAR(); GAPA(C1=__builtin_amdgcn_mfma_f32_32x32x16_bf16(kf[1],qr[0],negm,0,0,0), P0[6],P0[7],P0[8],P0[9],     pw0[2]=PKW(P0,4), pw0[3]=PKW(P0,6), pw0); \
    VRD(1); SBAR(); GAPA(C0=__builtin_amdgcn_mfma_f32_32x32x16_bf16(kf[2],qr[1],C0,0,0,0),   P0[10],P0[11],P0[12],P0[13], pw1[0]=PKW(P0,8), pw1[1]=PKW(P0,10), pw1); \
    VRD(5); SBAR(); GAPA(C1=__builtin_amdgcn_mfma_f32_32x32x16_bf16(kf[3],qr[1],C1,0,0,0),   P0[14],P0[15],P1[0],P1[1],   pw1[2]=PKW(P0,12),pw1[3]=PKW(P0,14), pw1); \
    VRD(2); SBAR(); GAPA(C0=__builtin_amdgcn_mfma_f32_32x32x16_bf16(kf[4],qr[2],C0,0,0,0),   P1[2],P1[3],P1[4],P1[5],     pw2[0]=PKW(P1,0), pw2[1]=PKW(P1,2), pw2); \
    VRD(6); SBAR(); GAPA(C1=__builtin_amdgcn_mfma_f32_32x32x16_bf16(kf[5],qr[2],C1,0,0,0),   P1[6],P1[7],P1[8],P1[9],     pw2[2]=PKW(P1,4), pw2[3]=PKW(P1,6), pw2); \
    VRD(3); SBAR(); GAPA(C0=__builtin_amdgcn_mfma_f32_32x32x16_bf16(kf[6],qr[3],C0,0,0,0),   P1[10],P1[11],P1[12],P1[13], pw3[0]=PKW(P1,8), pw3[1]=PKW(P1,10), pw3); \
    VRD(7); SBAR(); GAPA(C1=__builtin_amdgcn_mfma_f32_32x32x16_bf16(kf[7],qr[3],C1,0,0,0),   P1[14],P1[15],0.f,0.f,       pw3[2]=PKW(P1,12),pw3[3]=PKW(P1,14), pw3); \
    l_reg+=sacc; \
    if(GK){DMA_K((t)+3,sl_cur);} if(GV){DMA_V((t)+1,sl_next);} \
    CMASK(C0,C1,t); \
    { float a=MX3(C0[0],C0[1],C1[0]),b=MX3(C0[2],C0[3],C1[1]); a=MX3(a,C1[2],C1[3]); \
      _Pragma("unroll") for(int r=4;r<16;r+=4){a=MX3(a,C0[r],C0[r+1]);b=MX3(b,C0[r+2],C0[r+3]);a=MX3(a,C1[r],C1[r+1]);b=MX3(b,C1[r+2],C1[r+3]);} \
      float rm=__builtin_fmaxf(a,b); { auto rr=__builtin_amdgcn_permlane32_swap(__float_as_uint(rm),__float_as_uint(rm),false,false); rm=__builtin_fmaxf(__uint_as_float(rr[0]),__uint_as_float(rr[1])); } \
      resc=false; \
      if(__builtin_expect(__any(rm>(float)THRL),0)){ const float dl=__builtin_fmaxf(rm,0.f); mhat+=dl; \
        _Pragma("unroll") for(int r=0;r<16;++r){C0[r]-=dl;C1[r]-=dl;} \
        _Pragma("unroll") for(int r=0;r<16;++r)negm[r]=-mhat; asm volatile("":"+v"(negm)); \
        const float f=__builtin_amdgcn_exp2f(-dl); l_reg*=f; if(hi==0)wsf[r32]=f; resc=true; } } \
    SBAR(); \
    GAPB(o[0]=__builtin_amdgcn_mfma_f32_32x32x16_bf16(PAF(0),VFR(0),o[0],0,0,0), C0,0); \
    GAPB(o[1]=__builtin_amdgcn_mfma_f32_32x32x16_bf16(PAF(0),VFR(4),o[1],0,0,0), C0,4); \
    KRD(GL,0); GAPB(o[0]=__builtin_amdgcn_mfma_f32_32x32x16_bf16(PAF(1),VFR(1),o[0],0,0,0), C0,8); \
    KRD(GL,1); GAPB(o[1]=__builtin_amdgcn_mfma_f32_32x32x16_bf16(PAF(1),VFR(5),o[1],0,0,0), C0,12); \
    KRD(GL,2); GAPB(o[0]=__builtin_amdgcn_mfma_f32_32x32x16_bf16(PAF(2),VFR(2),o[0],0,0,0), C1,0); \
    KRD(GL,3); GAPB(o[1]=__builtin_amdgcn_mfma_f32_32x32x16_bf16(PAF(2),VFR(6),o[1],0,0,0), C1,4); \
    GAPB(o[0]=__builtin_amdgcn_mfma_f32_32x32x16_bf16(PAF(3),VFR(3),o[0],0,0,0), C1,8); \
    GAPB(o[1]=__builtin_amdgcn_mfma_f32_32x32x16_bf16(PAF(3),VFR(7),o[1],0,0,0), C1,12); \
    }while(0)
  int t=1;
  #undef CMASK
  #define CMASK(P0,P1,t) do{}while(0)
  for(;t+5<NT;t+=2){
    STEP(pB0,pB1,pA0,pA1,t,true,true,true);     WAIT_BAR(2); RESC(); ROT();
    STEP(pA0,pA1,pB0,pB1,t+1,true,true,true);   WAIT_BAR(2); RESC(); ROT();
  }
  #undef CMASK
  #define CMASK(P0,P1,t) do{}while(0)
  #define ENDW(tt) do{ if((tt)+3<NT){WAIT_BAR(2);} else if((tt)+2<NT){WAIT_BAR(1);} else {WAIT_BAR(0);} }while(0)
  for(;t+1<NT;t+=2){
    STEP(pB0,pB1,pA0,pA1,t,(t+3<NT),(t+1<NT),(t+1<NT));       ENDW(t);   RESC(); ROT();
    STEP(pA0,pA1,pB0,pB1,t+1,(t+4<NT),(t+2<NT),(t+2<NT));     ENDW(t+1); RESC(); ROT();
  }
  STEP(pB0,pB1,pA0,pA1,NT-1,false,false,false); RESC();
  { float sacc=pB0[0]+pB0[1]; _Pragma("unroll") for(int r=2;r<16;++r)sacc+=pB0[r]; _Pragma("unroll") for(int r=0;r<16;++r)sacc+=pB1[r]; l_reg+=sacc;
    pw0=(u32x4){PKW(pB0,0),PKW(pB0,2),PKW(pB0,4),PKW(pB0,6)};pw1=(u32x4){PKW(pB0,8),PKW(pB0,10),PKW(pB0,12),PKW(pB0,14)};pw2=(u32x4){PKW(pB1,0),PKW(pB1,2),PKW(pB1,4),PKW(pB1,6)};pw3=(u32x4){PKW(pB1,8),PKW(pB1,10),PKW(pB1,12),PKW(pB1,14)};
    SBAR(); pv(o,vb0+sl_cur,PAF(0),PAF(1),PAF(2),PAF(3)); }
  #undef PKW
  #undef PAF
  #undef VFR
  #undef PIN
  #undef MX3
  #undef GAPA
  #undef GAPB
  #undef EX
  #undef VRD
  #undef KRD
  #undef STEP
  #undef ENDW
  {auto rr=__builtin_amdgcn_permlane32_swap(__float_as_uint(l_reg),__float_as_uint(l_reg),false,false);l_reg=__uint_as_float(rr[0])+__uint_as_float(rr[1]);}
  if(hi==0)wsf[32+r32]=l_reg;asm volatile("s_waitcnt lgkmcnt(0)":::"memory");
  float rli[16];
  #pragma unroll
  for(int r=0;r<16;++r)rli[r]=__builtin_amdgcn_rcpf(wsf[32+crow(r,hi)]);
  bf16*Ow=O+(rowbase+q0+wid*QBLK)*PO;
  { bf16*stg=(bf16*)(shm+LDS_OST)+wid*2048;
    #pragma unroll
    for(int r=0;r<16;++r){const int orow=crow(r,hi);
      #pragma unroll
      for(int d0=0;d0<2;++d0)stg[orow*64+d0*32+r32]=__float2bfloat16(o[d0][r]*rli[r]);}
    asm volatile("s_waitcnt lgkmcnt(0)":::"memory");
    #pragma unroll
    for(int i=0;i<4;++i){const int row=i*8+(lane>>3),ch=lane&7; const u32x4 v=*(const u32x4*)(stg+row*64+ch*8); ATTN_STORE16(Ow+(long)row*PO+ch*8,v);} }
  asm volatile("s_waitcnt lgkmcnt(0)\n\ts_barrier":::"memory");
  #undef DMA_K
  #undef DMA_V
  #undef CMASK
  #undef START
  #undef RESC
  #undef ROT
}
constexpr int ATTN_LDS_BYTES=LDS_BYTES;
#undef SBAR
#undef WAIT_BAR
}
namespace cg = cooperative_groups;
constexpr int NWAVES = 8;
constexpr int M = 32768, DMODEL = 1024, DFF = 2816, SEQ = 2048, EV_IN = 2304, OD_IN = 1536;
constexpr float EPS = 1e-6f;
constexpr size_t MiB = 1u << 20;
constexpr size_t WS_SSQ = 432 * MiB;
constexpr size_t WS_SGUW = 2 * MiB;
constexpr size_t WS_W1T = 4 * MiB;
constexpr size_t WS_W2T = 92 * MiB;
constexpr size_t WS_EVIN = 136 * MiB;
constexpr size_t WS_EVOUT = 145 * MiB;
constexpr size_t WS_ODIN = 149 * MiB;
constexpr size_t WS_ODOUT = 155 * MiB;
constexpr size_t WS_XB = 160 * MiB;
constexpr size_t WS_PART = 224 * MiB, PART_BYTES = 26 * MiB, PART_E = PART_BYTES / 2;
constexpr size_t WS_ACT = WS_PART;
constexpr size_t WS_PROJ = WS_PART;
constexpr size_t WS_MIX = WS_PART + 18 * MiB;
constexpr size_t WS_BAR = 440 * MiB, BAR_BYTES = 32768;
constexpr size_t WS_END = 441 * MiB;
constexpr int RING_BYTES = 131072, PTAB_BYTES = 4096, MISC_OFF = RING_BYTES + PTAB_BYTES, LDS_BYTES = 147456;

#define GAS __attribute__((address_space(1)))
#define LAS __attribute__((address_space(3)))
typedef unsigned short bf16;
typedef unsigned v4u __attribute__((ext_vector_type(4)));
typedef unsigned v2u __attribute__((ext_vector_type(2)));
typedef float f32x4 __attribute__((ext_vector_type(4)));
typedef short bf16x8 __attribute__((ext_vector_type(8)));
__device__ __forceinline__ long prow(int row, int pitch) { return (long)(row >> 12) * (long)PART_E + (long)(row & 4095) * pitch; }
#define LDS_WAIT() asm volatile("s_waitcnt lgkmcnt(0)" ::: "memory")
__device__ __forceinline__ unsigned f2bf(float f) { unsigned u = __builtin_bit_cast(unsigned, f); return (u + 0x7fffu + ((u >> 16) & 1u)) >> 16; }
__device__ __forceinline__ unsigned pk2(float lo, float hi) { return pg8::cvt_pk_bf16(lo, hi); }
__device__ __forceinline__ float bflo(unsigned u) { return __builtin_bit_cast(float, u << 16); }
__device__ __forceinline__ float bfhi(unsigned u) { return __builtin_bit_cast(float, u & 0xffff0000u); }
#define UNPACK8(X_, W_) do { X_[0] = bflo(W_[0]); X_[1] = bfhi(W_[0]); X_[2] = bflo(W_[1]); X_[3] = bfhi(W_[1]); X_[4] = bflo(W_[2]); X_[5] = bfhi(W_[2]); X_[6] = bflo(W_[3]); X_[7] = bfhi(W_[3]); } while (0)
__device__ __forceinline__ float gelu_tanh(float x) {
    const float z2 = 1.5957691216057308f * (x + 0.044715f * x * x * x);
    return x * __builtin_amdgcn_rcpf(1.0f + __builtin_amdgcn_exp2f(-1.4426950408889634f * z2));
}
__device__ __forceinline__ float wave_sum(float v) {
#pragma unroll
    for (int o = 1; o < 64; o <<= 1) v += __shfl_xor(v, o);
    return v;
}

struct Args { const float* in[21]; float* out; unsigned char* ws; };
#define XB_TMO      128
#define XB_XCNT(j)  (256  + 64 * (j))
#define XB_XSUB(j)  (1280 + 64 * (j))
#define XB_XGEN(j)  (2304 + 64 * (j))
#define XB_TOP      3328
#define XB_TOPGEN   3392
#define XCD_BAR_WORDS 3456
#define XB_SPIN_CAP (1u << 18)

__device__ __forceinline__ unsigned xb_ld(unsigned* p)              { return __hip_atomic_load(p, __ATOMIC_RELAXED, __HIP_MEMORY_SCOPE_AGENT); }
__device__ __forceinline__ unsigned xb_add(unsigned* p, unsigned v) { return __hip_atomic_fetch_add(p, v, __ATOMIC_RELAXED, __HIP_MEMORY_SCOPE_AGENT); }
__device__ __forceinline__ unsigned xb_xcc_id() { return (unsigned)__builtin_amdgcn_s_getreg((3 << 11) | 20) & 0xFu; }
#define XB_SPIN(cond, bar) do { unsigned _sp = 0; while (cond) { __builtin_amdgcn_s_sleep(1); \
    if ((++_sp & 255u) == 0u) { if (xb_ld(&(bar)[XB_TMO])) break; if (_sp > XB_SPIN_CAP) { atomicAdd(&(bar)[XB_TMO], 1u); break; } } } } while (0)

struct XcdBarrier {
    unsigned* bar; unsigned x;
    volatile LAS unsigned* st;
};

__device__ __forceinline__ XcdBarrier xcd_barrier_post(unsigned* bar, volatile LAS unsigned* st) {
    XcdBarrier b; b.bar = bar; b.x = xb_xcc_id(); b.st = st;
    if (threadIdx.x == 0) (void)xb_add(&bar[XB_XCNT(b.x)], 1u);
    return b;
}
__device__ __forceinline__ void xcd_barrier_complete(unsigned* bar, unsigned x, unsigned& nloc, unsigned& nx) {
    const unsigned G = gridDim.x * gridDim.y * gridDim.z;
    unsigned sum, cnt, mine, sp = 0u;
    for (;;) {
        sum = 0u; cnt = 0u; mine = 0u;
#pragma unroll
        for (unsigned j = 0; j < 16; ++j) { const unsigned c = xb_ld(&bar[XB_XCNT(j)]); sum += c; cnt += (c > 0u) ? 1u : 0u; mine = (j == x) ? c : mine; }
        if (sum == G) break;
        __builtin_amdgcn_s_sleep(1);
        if ((++sp & 255u) == 0u) { if (xb_ld(&bar[XB_TMO])) break; if (sp > XB_SPIN_CAP) { atomicAdd(&bar[XB_TMO], 1u); break; } }
    }
    nloc = mine > 0u ? mine : 1u; nx = cnt > 0u ? cnt : 1u;
}

__device__ __forceinline__ void xcd_barrier(const XcdBarrier& b) {
    asm volatile("s_waitcnt vmcnt(0)" ::: "memory");
    __syncthreads();
    if (threadIdx.x == 0) {
        unsigned* bar = b.bar;
        __builtin_amdgcn_s_waitcnt(0);
        unsigned nloc = b.st[0], nx = b.st[1];
        if (nloc == 0u) { xcd_barrier_complete(bar, b.x, nloc, nx); b.st[0] = nloc; b.st[1] = nx; }
        const unsigned old = xb_add(&bar[XB_XSUB(b.x)], 1u);
        const unsigned gen = old / nloc;
        if (old + 1u == (gen + 1u) * nloc) {
            __builtin_amdgcn_fence(__ATOMIC_RELEASE, "agent");
            asm volatile("s_waitcnt vmcnt(0)" ::: "memory");
            const unsigned og = xb_add(&bar[XB_TOP], 1u);
            const unsigned tg = og / nx;
            if (og + 1u == (tg + 1u) * nx) xb_add(&bar[XB_TOPGEN], 1u);
            else XB_SPIN(xb_ld(&bar[XB_TOPGEN]) == tg, bar);
            __builtin_amdgcn_fence(__ATOMIC_ACQUIRE, "agent");
            xb_add(&bar[XB_XGEN(b.x)], 1u);
            asm volatile("s_waitcnt vmcnt(0)" ::: "memory");
        } else {
            XB_SPIN(xb_ld(&bar[XB_XGEN(b.x)]) == gen, bar);
            __builtin_amdgcn_fence(__ATOMIC_ACQUIRE, "agent");
            asm volatile("s_waitcnt vmcnt(0)" ::: "memory");
        }
    }
    __syncthreads();
}


enum { I_X = 0, I_F1N, I_F1WI, I_F1WO, I_MIXN, I_F2N, I_F2WI, I_F2WO, I_EVWI, I_EVCONV, I_EVQN, I_EVKN, I_EVWO, I_ODWI, I_ODPW, I_ODPS, I_ODSN, I_ODSW, I_ODSB, I_ODWO, I_FINN };

struct TrItem { const float* W; const float* gain; bf16* WT; int ldw, dstK, koff, k0, n0, drow; };
__device__ __forceinline__ TrItem tr_decode(const Args& a, int it) {
    unsigned char* ws = a.ws;
    constexpr int N_W1 = 8 * 2816, N_W2 = 8 * 1408, N_EI = 2 * 1152, N_EO = 2 * 512, N_OI = 2 * 768;
    TrItem t; t.gain = nullptr; t.koff = 0; int r = it, nblk, mode = 0;
    if (r < N_W1) { const int m = r / 2816; r -= m * 2816; const int l = m & 3, f2 = m >> 2; t.W = a.in[f2 ? I_F2WI : I_F1WI] + (size_t)l * 1024 * 5632; t.gain = a.in[f2 ? I_F2N : I_F1N] + l * 1024;
        t.WT = (bf16*)(ws + WS_W1T) + (size_t)m * 5632 * 1024; t.ldw = 5632; t.dstK = 1024; nblk = 176; mode = 1; }
    else if ((r -= N_W1) < N_W2) { const int m = r / 1408; r -= m * 1408; const int l = m & 3, f2 = m >> 2; t.W = a.in[f2 ? I_F2WO : I_F1WO] + (size_t)l * 2816 * 1024;
        t.WT = (bf16*)(ws + WS_W2T) + (size_t)m * 1024 * 2816; t.ldw = 1024; t.dstK = 2816; nblk = 32; }
    else if ((r -= N_W2) < N_EI) { const int j = r / 1152; r -= j * 1152; t.W = a.in[I_EVWI] + (size_t)j * 1024 * 2304; t.gain = a.in[I_MIXN] + (2 * j) * 1024;
        t.WT = (bf16*)(ws + WS_EVIN) + (size_t)j * 2304 * 1024; t.ldw = 2304; t.dstK = 1024; nblk = 72; }
    else if ((r -= N_EI) < N_EO) { const int j = r / 512; r -= j * 512; t.W = a.in[I_EVWO] + (size_t)j * 1024 * 1024;
        t.WT = (bf16*)(ws + WS_EVOUT) + (size_t)j * 1024 * 1024; t.ldw = 1024; t.dstK = 1024; nblk = 32; }
    else if ((r -= N_EO) < N_OI) { const int j = r / 768; r -= j * 768; t.W = a.in[I_ODWI] + (size_t)j * 1024 * 1536; t.gain = a.in[I_MIXN] + (2 * j + 1) * 1024;
        t.WT = (bf16*)(ws + WS_ODIN) + (size_t)j * 1536 * 1024; t.ldw = 1536; t.dstK = 1024; nblk = 48; }
    else { r -= N_OI; const int j = r / 256; r -= j * 256; t.W = a.in[I_ODWO] + (size_t)j * 1024 * 1024 + (size_t)512 * 1024;
        t.WT = (bf16*)(ws + WS_ODOUT) + (size_t)j * 1024 * 1024; t.ldw = 1024; t.dstK = 1024; t.koff = 512; nblk = 32; }
    const int kb = r / nblk, nb = r - kb * nblk; t.k0 = 64 * kb; t.n0 = 32 * nb; t.drow = t.n0;
    if (mode == 1) { const int nn = t.n0 < 2816 ? t.n0 : t.n0 - 2816; t.drow = (nn >> 7) * 256 + (nn & 127) + (t.n0 < 2816 ? 0 : 128); }
    return t;
}
__device__ __forceinline__ void tr_load(const TrItem& t, float (&v)[32], int lane) {
#pragma unroll
    for (int i = 0; i < 32; ++i) { const int kk = 2 * i + (lane >> 5); v[i] = t.W[(size_t)(t.k0 + kk) * t.ldw + t.n0 + (lane & 31)]; }
}
__device__ __forceinline__ void tr_store(const TrItem& t, const float (&v)[32], LAS float* scr, int lane) {
#pragma unroll
    for (int i = 0; i < 32; ++i) { const int kk = 2 * i + (lane >> 5); float w = v[i]; if (t.gain) w *= t.gain[t.k0 + kk]; scr[kk * 33 + (lane & 31)] = w; }
    LDS_WAIT(); asm volatile("" ::: "memory");
    const int c = lane & 7;
#pragma unroll
    for (int j = 0; j < 4; ++j) { const int n = (lane >> 3) + 8 * j; const LAS float* s = scr + (8 * c) * 33 + n;
        v4u o; o.x = pk2(s[0 * 33], s[1 * 33]); o.y = pk2(s[2 * 33], s[3 * 33]); o.z = pk2(s[4 * 33], s[5 * 33]); o.w = pk2(s[6 * 33], s[7 * 33]);
        *(GAS v4u*)(t.WT + (size_t)(t.drow + n) * t.dstK + t.koff + t.k0 + 8 * c) = o; }
    LDS_WAIT(); asm volatile("" ::: "memory");
}

__device__ __forceinline__ void p0_prologue(const Args& a, LAS unsigned char* lds, int gw, int NGW, int gtid, int GT, int wave, int lane) {
    unsigned char* ws = a.ws;
    LAS float* scr = (LAS float*)(lds + wave * 16384);
    constexpr int NITEMS = 8 * 2816 + 8 * 1408 + 2 * 1152 + 2 * 512 + 2 * 768 + 2 * 256;
    for (int it = gw; it < NITEMS; it += 2 * NGW) {
        const int it2 = it + NGW; const bool two = it2 < NITEMS;
        const TrItem t0 = tr_decode(a, it), t1 = tr_decode(a, two ? it2 : it);
        float v0[32], v1[32];
        tr_load(t0, v0, lane); tr_load(t1, v1, lane);
        tr_store(t0, v0, scr, lane);
        if (two) tr_store(t1, v1, scr, lane);
    }
    for (int it = gw; it < 2048; it += NGW) {
        const int j = it >> 10, g = (it >> 8) & 3, cb = (it >> 4) & 15, n = (it & 15) * 64 + lane;
        const float* pw = a.in[I_ODPW] + ((size_t)(j * 4 + g) * 128 + cb * 8) * 128; const float* sc = a.in[I_ODPS] + j * 512 + g * 128; const float* wo = a.in[I_ODWO] + (size_t)j * 1024 * 1024 + (size_t)(g * 128) * 1024 + n;
        float acc[8];
#pragma unroll
        for (int e = 0; e < 8; ++e) acc[e] = 0.f;
        for (int d0 = 0; d0 < 128; d0 += 16) { float wv[16];
#pragma unroll
            for (int d = 0; d < 16; ++d) wv[d] = wo[(size_t)(d0 + d) * 1024];
#pragma unroll
            for (int d = 0; d < 16; ++d) { const float w = wv[d] * sc[d0 + d];
#pragma unroll
                for (int e = 0; e < 8; ++e) acc[e] += pw[e * 128 + d0 + d] * w; } }
        v4u o; o.x = pk2(acc[0], acc[1]); o.y = pk2(acc[2], acc[3]); o.z = pk2(acc[4], acc[5]); o.w = pk2(acc[6], acc[7]);
        *(v4u*)((bf16*)(ws + WS_ODOUT) + (size_t)j * 1024 * 1024 + (size_t)n * 1024 + g * 128 + cb * 8) = o;
    }
    { const float* x = a.in[I_X]; bf16* xb = (bf16*)(ws + WS_XB); float* ssq0 = (float*)(ws + WS_SSQ);
      for (int m = gw; m < M; m += 2 * NGW) { const int m2 = m + NGW;
          const f32x4* xr = (const f32x4*)(x + (size_t)m * 1024) + lane; const f32x4* xr2 = (const f32x4*)(x + (size_t)(m2 < M ? m2 : m) * 1024) + lane; f32x4 v[4], v2[4]; float s = 0.f, s2 = 0.f;
#pragma unroll
          for (int j = 0; j < 4; ++j) { v[j] = xr[64 * j]; v2[j] = xr2[64 * j]; }
#pragma unroll
          for (int j = 0; j < 4; ++j) { s += (v[j].x * v[j].x + v[j].y * v[j].y) + (v[j].z * v[j].z + v[j].w * v[j].w); s2 += (v2[j].x * v2[j].x + v2[j].y * v2[j].y) + (v2[j].z * v2[j].z + v2[j].w * v2[j].w); }
          s = wave_sum(s); s2 = wave_sum(s2);
          if (lane == 0) *(f32x4*)(ssq0 + 4 * (size_t)m) = (f32x4){s, 0.f, 0.f, 0.f};
          v2u* o8 = (v2u*)(xb + (size_t)m * 1024) + lane;
#pragma unroll
          for (int j = 0; j < 4; ++j) { v2u w; w.x = pk2(v[j].x, v[j].y); w.y = pk2(v[j].z, v[j].w); o8[64 * j] = w; }
          if (m2 < M) { if (lane == 0) *(f32x4*)(ssq0 + 4 * (size_t)m2) = (f32x4){s2, 0.f, 0.f, 0.f};
              v2u* o82 = (v2u*)(xb + (size_t)m2 * 1024) + lane;
#pragma unroll
              for (int j = 0; j < 4; ++j) { v2u w; w.x = pk2(v2[j].x, v2[j].y); w.y = pk2(v2[j].z, v2[j].w); o82[64 * j] = w; } } } }
    { const f32x4* s = (const f32x4*)a.in[I_ODSW]; v2u* o = (v2u*)(ws + WS_SGUW); for (int i = gtid; i < 2 * 4 * 128 * 128 / 4; i += GT) { const f32x4 v = s[i]; v2u w; w.x = pk2(v.x, v.y); w.y = pk2(v.z, v.w); o[i] = w; } }
}

__device__ __forceinline__ void even_qk(bf16* proj, const float* qg, const float* kg, int R0, int NR, int lt, int NT) {
    for (int it = lt; it < NR * 80; it += NT) {
        const int tl = it / 80, tok = R0 + tl, r = it - tl * 80, h = r >> 3, sub = r & 7;
        bf16* p = proj + prow(tok, EV_IN) + 1536 + h * 64 + sub * 8;
        const v4u w = *(const v4u*)p; float x[8]; UNPACK8(x, w);
        float s = 0.f;
#pragma unroll
        for (int e = 0; e < 8; ++e) s += x[e] * x[e];
        s += __shfl_xor(s, 1); s += __shfl_xor(s, 2); s += __shfl_xor(s, 4);
        const float rs = __builtin_amdgcn_rsqf(s * (1.0f / 64.0f) + EPS);
        const float* gn = (h < 8 ? qg : kg) + sub * 8;
        const f32x4 g0 = *(const f32x4*)gn, g1 = *(const f32x4*)(gn + 4);
        const float gv[8] = {g0.x, g0.y, g0.z, g0.w, g1.x, g1.y, g1.z, g1.w};
        const int t = tok & (SEQ - 1); const float pos = (float)(sub < 4 ? (t >> 6) : (t & 63));
        const float osc = h < 8 ? attn_body::C2 : 1.0f;
        float o[8];
#pragma unroll
        for (int e = 0; e < 4; ++e) { const int j = (sub & 3) * 4 + e; const float inv = __builtin_amdgcn_exp2f(-(float)j * 0.83048202372184059f);
            const float ang = pos * inv, c = __cosf(ang), sn = __sinf(ang);
            const float x0 = x[2 * e] * rs * gv[2 * e], x1 = x[2 * e + 1] * rs * gv[2 * e + 1];
            o[2 * e] = (x0 * c - x1 * sn) * osc; o[2 * e + 1] = (x0 * sn + x1 * c) * osc; }
        v4u ow; ow.x = pk2(o[0], o[1]); ow.y = pk2(o[2], o[3]); ow.z = pk2(o[4], o[5]); ow.w = pk2(o[6], o[7]);
        *(v4u*)p = ow;
    }
}
__device__ __forceinline__ void even_conv(const bf16* proj, bf16* mix, const float* convw, int R0, int NR, int lt, int NT) {
    for (int it = lt; it < NR * 64; it += NT) {
        const int tok = R0 + (it >> 6), c = (it & 63) * 8, t = tok & (SEQ - 1);
        const bf16* pr = proj + prow(tok, EV_IN) + c;
        const v4u zero = (v4u){0u, 0u, 0u, 0u};
        const v4u wb = *(const v4u*)pr, wc1 = *(const v4u*)(pr + 512), wh1 = *(const v4u*)(pr + 1024);
        const v4u wc0 = t > 0 ? *(const v4u*)(pr - EV_IN + 512) : zero, wh0 = t > 0 ? *(const v4u*)(pr - EV_IN + 1024) : zero;
        const v4u wc2 = t < SEQ - 1 ? *(const v4u*)(pr + EV_IN + 512) : zero, wh2 = t < SEQ - 1 ? *(const v4u*)(pr + EV_IN + 1024) : zero;
        float gb[8], c0[8], h0[8], c1[8], h1[8], c2[8], h2[8];
        UNPACK8(gb, wb); UNPACK8(c0, wc0); UNPACK8(h0, wh0); UNPACK8(c1, wc1); UNPACK8(h1, wh1); UNPACK8(c2, wc2); UNPACK8(h2, wh2);
        const f32x4 a0 = *(const f32x4*)(convw + c), a1 = *(const f32x4*)(convw + c + 4), b0 = *(const f32x4*)(convw + 512 + c), b1 = *(const f32x4*)(convw + 512 + c + 4), d0 = *(const f32x4*)(convw + 1024 + c), d1 = *(const f32x4*)(convw + 1024 + c + 4);
        const float w0[8] = {a0.x, a0.y, a0.z, a0.w, a1.x, a1.y, a1.z, a1.w}, w1[8] = {b0.x, b0.y, b0.z, b0.w, b1.x, b1.y, b1.z, b1.w}, w2[8] = {d0.x, d0.y, d0.z, d0.w, d1.x, d1.y, d1.z, d1.w};
        float o[8];
#pragma unroll
        for (int e = 0; e < 8; ++e) o[e] = gb[e] * (w0[e] * (c0[e] * h0[e]) + w1[e] * (c1[e] * h1[e]) + w2[e] * (c2[e] * h2[e]));
        v4u ow; ow.x = pk2(o[0], o[1]); ow.y = pk2(o[2], o[3]); ow.z = pk2(o[4], o[5]); ow.w = pk2(o[6], o[7]);
        *(v4u*)(mix + prow(tok, 1024) + c) = ow;
    }
}

template <int R> __device__ __forceinline__ void pool_item(const bf16* pb, bf16* mp, int t) {
    v4u w[2 * R + 1];
#pragma unroll
    for (int d = 0; d <= 2 * R; ++d) { const int tt = t + d - R; w[d] = (tt >= 0 && tt < SEQ) ? *(const v4u*)(pb + (size_t)tt * OD_IN) : (v4u){0u, 0u, 0u, 0u}; }
    float acc[8];
#pragma unroll
    for (int e = 0; e < 8; ++e) acc[e] = 0.f;
#pragma unroll
    for (int d = 0; d <= 2 * R; ++d) { float x[8]; UNPACK8(x, w[d]);
#pragma unroll
        for (int e = 0; e < 8; ++e) acc[e] += x[e]; }
    const int lo = t - R < 0 ? 0 : t - R, hi = t + R > SEQ - 1 ? SEQ - 1 : t + R;
    const float inv = 1.0f / (float)(hi - lo + 1);
    float xs[8]; UNPACK8(xs, w[R]);
    v4u ow; ow.x = pk2(acc[0] * inv - xs[0], acc[1] * inv - xs[1]); ow.y = pk2(acc[2] * inv - xs[2], acc[3] * inv - xs[3]);
    ow.z = pk2(acc[4] * inv - xs[4], acc[5] * inv - xs[5]); ow.w = pk2(acc[6] * inv - xs[6], acc[7] * inv - xs[7]);
    *(v4u*)mp = ow;
}
__device__ __forceinline__ void odd_pool(const bf16* proj, bf16* mix, int R0, int NR, int w, int NW, int lane) {
    for (int wi = w; wi < NR; wi += NW) {
        const int g = wi & 3, tok = R0 + (wi >> 2) * 4 + (lane >> 4), c = g * 128 + (lane & 15) * 8, t = tok & (SEQ - 1);
        const bf16* pb = proj + prow(tok - t, OD_IN) + c; bf16* mp = mix + prow(tok, 1024) + c;
        if (g == 0) pool_item<1>(pb, mp, t); else if (g == 1) pool_item<2>(pb, mp, t); else if (g == 2) pool_item<4>(pb, mp, t); else pool_item<8>(pb, mp, t);
    }
}

__device__ __forceinline__ void sgu_chunk(int ch, const bf16* proj, const bf16* sguw, const float* norm_g, const float* b_s, bf16* mix, LAS unsigned char* lds, int tid, int lane, int wave) {
    LAS float* rstd = (LAS float*)lds;
    LAS unsigned short* vnT = (LAS unsigned short*)(lds + 512);
    const size_t row0 = 0; proj += prow(ch * 128, OD_IN); mix += prow(ch * 128, 1024);
    const int q = tid >> 2, part = tid & 3, fr = lane & 15, fq = lane >> 4;
    { const bf16* vp = proj + (row0 + q) * OD_IN + 1024 + part * 128; float s = 0.f;
#pragma unroll 4
      for (int i = 0; i < 16; ++i) { const v4u w = *(const v4u*)(vp + 8 * i); float x[8]; UNPACK8(x, w);
#pragma unroll
          for (int e = 0; e < 8; ++e) { const float gl = gelu_tanh(x[e]); s += gl * gl; } }
      s += __shfl_xor(s, 1); s += __shfl_xor(s, 2);
      if (part == 0) rstd[q] = __builtin_amdgcn_rsqf(s * (1.0f / 512.0f) + EPS); }
    __syncthreads();
    for (int g = 0; g < 4; ++g) {
        { const float rs = rstd[q]; const int cs = part * 32; const bf16* vp = proj + (row0 + q) * OD_IN + 1024 + g * 128 + cs; const float* ng = norm_g + g * 128 + cs;
#pragma unroll
          for (int i = 0; i < 4; ++i) { const v4u w = *(const v4u*)(vp + 8 * i); float x[8]; UNPACK8(x, w);
              const f32x4 n0 = *(const f32x4*)(ng + 8 * i), n1 = *(const f32x4*)(ng + 8 * i + 4); const float nv[8] = {n0.x, n0.y, n0.z, n0.w, n1.x, n1.y, n1.z, n1.w};
#pragma unroll
              for (int e = 0; e < 8; ++e) vnT[(cs + 8 * i + e) * 136 + q] = (unsigned short)f2bf(gelu_tanh(x[e]) * rs * nv[e]); } }
        __syncthreads();
        f32x4 acc[8];
#pragma unroll
        for (int n = 0; n < 8; ++n) acc[n] = (f32x4){0.f, 0.f, 0.f, 0.f};
        const int p = 16 * wave + fr;
#pragma unroll
        for (int ks = 0; ks < 4; ++ks) { const bf16x8 af = *(const bf16x8*)(sguw + ((size_t)(g * 128 + p) * 128 + 32 * ks + 8 * fq));
#pragma unroll
            for (int n = 0; n < 8; ++n) { const bf16x8 bfv = *(const LAS bf16x8*)(vnT + (16 * n + fr) * 136 + 32 * ks + 8 * fq);
                acc[n] = __builtin_amdgcn_mfma_f32_16x16x32_bf16(bfv, af, acc[n], 0, 0, 0); } }
        const float bias = b_s[g * 128 + p];
        const bf16* up = proj + (row0 + p) * OD_IN + 512 + g * 128 + 4 * fq; bf16* op = mix + (row0 + p) * 1024 + 512 + g * 128 + 4 * fq;
#pragma unroll
        for (int n = 0; n < 8; ++n) { const v2u uw = *(const v2u*)(up + 16 * n);
            v2u ow; ow.x = pk2(gelu_tanh(bflo(uw.x)) * (acc[n][0] + bias), gelu_tanh(bfhi(uw.x)) * (acc[n][1] + bias)); ow.y = pk2(gelu_tanh(bflo(uw.y)) * (acc[n][2] + bias), gelu_tanh(bfhi(uw.y)) * (acc[n][3] + bias));
            *(v2u*)(op + 16 * n) = ow; }
        __syncthreads();
    }
}

#define LB_SUB(j) (3456 + 64 * (j))
#define LB_GEN(j) (4480 + 64 * (j))
struct Ctx { int tid, lane, wave, G, vb, bi, nb, R0, NR, w, NW, lt, NT; };
__device__ __forceinline__ Ctx mkctx(LAS unsigned char* lds) {
    Ctx c; int t = threadIdx.x; asm volatile("" : "+v"(t)); int g = gridDim.x, b = blockIdx.x; asm volatile("" : "+s"(g), "+s"(b));
    volatile LAS unsigned* MISC = (volatile LAS unsigned*)(lds + MISC_OFF);
    const int loc = __builtin_amdgcn_readfirstlane((int)MISC[4]), xv = __builtin_amdgcn_readfirstlane((int)MISC[6]), rank = __builtin_amdgcn_readfirstlane((int)MISC[7]);
    c.tid = t; c.lane = t & 63; c.wave = __builtin_amdgcn_readfirstlane(t >> 6); c.G = g;
    const int vcu = (g % 8 == 0) ? (b % 8) * (g / 8) + b / 8 : b;
    c.vb = loc ? rank * 8 + xv : b;
    c.bi = loc ? rank : vcu; c.nb = loc ? 32 : g; c.R0 = loc ? 4096 * xv : 0; c.NR = loc ? 4096 : M;
    c.w = c.bi * NWAVES + c.wave; c.NW = c.nb * NWAVES; c.lt = c.bi * (NWAVES * 64) + t; c.NT = c.nb * NWAVES * 64; return c;
}
__device__ __forceinline__ const Args* kargs() { auto p = __builtin_amdgcn_kernarg_segment_ptr(); asm volatile("" : "+s"(p)); return (const Args*)p; }
#define CG_SYNC() do { asm volatile("s_waitcnt vmcnt(0) lgkmcnt(0)" ::: "memory"); __syncthreads(); cg::this_grid().sync(); __builtin_amdgcn_fence(__ATOMIC_ACQUIRE, "agent"); asm volatile("s_waitcnt vmcnt(0)" ::: "memory"); } while (0)
__device__ __forceinline__ void seam(LAS unsigned char* lds) {
    volatile LAS unsigned* MISC = (volatile LAS unsigned*)(lds + MISC_OFF);
    unsigned* bar = (unsigned*)(kargs()->ws + WS_BAR);
    if (__builtin_amdgcn_readfirstlane((int)MISC[4])) {
        asm volatile("s_waitcnt vmcnt(0)" ::: "memory");
        __syncthreads();
        if (threadIdx.x == 0) {
            __builtin_amdgcn_s_waitcnt(0);
            const unsigned x = MISC[5];
            const unsigned old = xb_add(&bar[LB_SUB(x)], 1u), gen = old >> 5;
            if ((old & 31u) == 31u) xb_add(&bar[LB_GEN(x)], 1u);
            else XB_SPIN(xb_ld(&bar[LB_GEN(x)]) == gen, bar);
            __builtin_amdgcn_fence(__ATOMIC_ACQUIRE, "agent");
            asm volatile("s_waitcnt vmcnt(0)" ::: "memory");
        }
        __syncthreads();
    } else { XcdBarrier b_; b_.bar = bar; b_.x = xb_xcc_id(); b_.st = MISC; xcd_barrier(b_); }
}
#define GRID_SYNC() seam(lds)

__global__ void __launch_bounds__(NWAVES * 64, 2) mega_fwd(Args args_unused) {
    extern __shared__ __attribute__((aligned(16))) unsigned char lds_raw[];
    LAS unsigned char* lds = (LAS unsigned char*)lds_raw;
    if (threadIdx.x == 0) {
        volatile LAS unsigned* MISC = (volatile LAS unsigned*)(lds + MISC_OFF); unsigned* bar = (unsigned*)(kargs()->ws + WS_BAR);
        const unsigned x = xb_xcc_id(); const unsigned rank = xb_add(&bar[XB_XCNT(x)], 1u);
        MISC[0] = 0u; MISC[1] = 0u; MISC[4] = 0u; MISC[5] = x; MISC[6] = 0u; MISC[7] = rank;
    }
    __syncthreads();
    for (int rp = 0; rp <= 0; ++rp) { const Ctx c = mkctx(lds); const Args* A = kargs(); p0_prologue(*A, lds, c.w, c.NW, c.lt, c.NT, c.wave, c.lane); }
    CG_SYNC();
    if (threadIdx.x == 0) {
        volatile LAS unsigned* MISC = (volatile LAS unsigned*)(lds + MISC_OFF); unsigned* bar = (unsigned*)(kargs()->ws + WS_BAR);
        const unsigned x = MISC[5]; unsigned npop = 0u, below = 0u; bool ok = gridDim.x == 256u;
        for (unsigned j = 0; j < 16; ++j) { const unsigned cnt = xb_ld(&bar[XB_XCNT(j)]); if (cnt) { ++npop; ok = ok && cnt == 32u; if (j < x) ++below; } }
        ok = ok && npop == 8u && MISC[7] < 32u;
        MISC[6] = below; MISC[4] = ok ? 1u : 0u;
    }
    __syncthreads();

    for (int j = 0; j < 12; ++j) {
        const int l = j / 3, kind = j - 3 * l;
        if (kind != 1) {
            const int wi = (kind == 2 ? 4 : 0) + l;
            { const Ctx c = mkctx(lds); const Args* A = kargs(); unsigned char* ws = A->ws;
              pg8::Gemm g{(const bf16*)(ws + WS_XB), (const bf16*)(ws + WS_W1T) + (size_t)wi * 5632 * 1024, M, 2 * DFF, DMODEL, 0}; pg8::StaticOrder S; S.init(M, 2 * DFF, c.G, c.vb);
              pg8::EpiSwiGLU E{(bf16*)(ws + WS_ACT), DFF, (const float*)(ws + WS_SSQ) + (size_t)j * M * 4, (long)PART_E - 4096L * DFF};
              pg8::gemm_phase<pg8::EpiSwiGLU, pg8::StaticOrder, true, true>(lds, g, S, E); }
            GRID_SYNC();
        } else {
            const int jj = l >> 1; const bool even = (l & 1) == 0;
            { const Ctx c = mkctx(lds); const Args* A = kargs(); unsigned char* ws = A->ws; const int N = even ? EV_IN : OD_IN;
              const bf16* wt = even ? (const bf16*)(ws + WS_EVIN) + (size_t)jj * EV_IN * 1024 : (const bf16*)(ws + WS_ODIN) + (size_t)jj * OD_IN * 1024;
              pg8::Gemm g{(const bf16*)(ws + WS_XB), wt, M, N, DMODEL, 0}; pg8::StaticOrder S; S.init(M, N, c.G, c.vb);
              pg8::EpiRowScale E{(bf16*)(ws + WS_PROJ), N, (const float*)(ws + WS_SSQ) + (size_t)j * M * 4, (long)PART_E - 4096L * N};
              pg8::gemm_phase<pg8::EpiRowScale, pg8::StaticOrder, true, true>(lds, g, S, E); }
            GRID_SYNC();
            if (even) {
                { const Ctx c = mkctx(lds); const Args* A = kargs(); unsigned char* ws = A->ws;
                  even_qk((bf16*)(ws + WS_PROJ), A->in[I_EVQN] + jj * 64, A->in[I_EVKN] + jj * 64, c.R0, c.NR, c.lt, c.NT);
                  even_conv((const bf16*)(ws + WS_PROJ), (bf16*)(ws + WS_MIX), A->in[I_EVCONV] + jj * 3 * 512, c.R0, c.NR, c.lt, c.NT); }
                GRID_SYNC();
                { const Ctx c = mkctx(lds); const Args* A = kargs(); unsigned char* ws = A->ws; const attn_body::bf16* PROJ = (const attn_body::bf16*)(ws + WS_PROJ); attn_body::bf16* MIX = (attn_body::bf16*)(ws + WS_MIX);
                  const int NU = (c.NR >> 11) * 64, b0 = c.R0 >> 11;
                  for (int ui = c.bi; ui < NU; ui += c.nb) {
                      const int b = b0 + (ui >> 6), h = (ui >> 3) & 7, qb = ui & 7, kvh = h >> 2;
                      const attn_body::bf16* Pp = PROJ + (long)(b >> 1) * (long)PART_E; attn_body::bf16* Mp = MIX + (long)(b >> 1) * (long)PART_E;
                      attn_body::attn_unit<8>(b & 1, qb, Pp + 1536 + h * 64, Pp + 2048 + kvh * 64, Pp + 2176 + kvh * 64, Mp + 512 + h * 64, (char*)lds_raw);
                  } }
            } else {
                { const Ctx c = mkctx(lds); const Args* A = kargs(); unsigned char* ws = A->ws; odd_pool((const bf16*)(ws + WS_PROJ), (bf16*)(ws + WS_MIX), c.R0, c.NR, c.w, c.NW, c.lane); }
                { const Ctx c = mkctx(lds); const Args* A = kargs(); unsigned char* ws = A->ws;
                  for (int ch = (c.R0 >> 7) + c.bi; ch < ((c.R0 + c.NR) >> 7); ch += c.nb)
                      sgu_chunk(ch, (const bf16*)(ws + WS_PROJ), (const bf16*)(ws + WS_SGUW) + (size_t)jj * 4 * 128 * 128, A->in[I_ODSN] + jj * 512, A->in[I_ODSB] + jj * 512, (bf16*)(ws + WS_MIX), lds, c.tid, c.lane, c.wave); }
            }
            GRID_SYNC();
        }
        { const Ctx c = mkctx(lds); const Args* A = kargs(); unsigned char* ws = A->ws; const bool ffn = kind != 1; const int jj = l >> 1;
          const bf16* wt = ffn ? (const bf16*)(ws + WS_W2T) + (size_t)((kind == 2 ? 4 : 0) + l) * 1024 * 2816 : ((l & 1) == 0 ? (const bf16*)(ws + WS_EVOUT) : (const bf16*)(ws + WS_ODOUT)) + (size_t)jj * 1024 * 1024;
          pg8::Gemm g{ffn ? (const bf16*)(ws + WS_ACT) : (const bf16*)(ws + WS_MIX), wt, M, DMODEL, ffn ? DFF : DMODEL, 2 * ((long)PART_E - 4096L * (ffn ? DFF : DMODEL))}; pg8::StaticOrder S; S.init(M, DMODEL, c.G, c.vb);
          pg8::EpiResid E{(bf16*)(ws + WS_XB), (float*)(ws + WS_SSQ) + (size_t)(j + 1) * M * 4, ffn ? 0.5f : 1.0f};
          pg8::gemm_phase<pg8::EpiResid, pg8::StaticOrder, true, true>(lds, g, S, E); }
        GRID_SYNC();
    }
    { const Ctx c = mkctx(lds); const Args* A = kargs(); float* out = A->out; const bf16* xb = (const bf16*)(A->ws + WS_XB); const float* ssq = (const float*)(A->ws + WS_SSQ) + (size_t)12 * M * 4; const f32x4* gf = (const f32x4*)A->in[I_FINN];
      for (int mi = c.w; mi < c.NR; mi += c.NW) { const int m = c.R0 + mi; const float rs = pg8::row_rs(ssq, m); const v2u* xr = (const v2u*)(xb + (size_t)m * 1024) + c.lane; f32x4* orow = (f32x4*)(out + (size_t)m * 1024) + c.lane;
#pragma unroll
          for (int q = 0; q < 4; ++q) { const v2u w = xr[64 * q]; const f32x4 v = {bflo(w.x), bfhi(w.x), bflo(w.y), bfhi(w.y)}; orow[64 * q] = v * rs * gf[c.lane + 64 * q]; } } }
}

extern "C" void kernel_launch(void* const* d_in, const int* in_sizes, int n_in, void* d_out, int out_size, void* d_ws, size_t ws_size, hipStream_t stream) {
    static int grid = 0;
    if (grid == 0) {
        if (n_in != 21 || in_sizes[0] != M * DMODEL || out_size != M * DMODEL || ws_size < WS_END) { fprintf(stderr, "kernel_launch: unexpected shapes (n_in %d, in0 %d, out %d, ws %zu)\n", n_in, n_in > 0 ? in_sizes[0] : -1, out_size, ws_size); grid = -1; return; }
        int dev = 0, cus = 0, per_cu = 0;
        if (hipGetDevice(&dev) != hipSuccess || hipDeviceGetAttribute(&cus, hipDeviceAttributeMultiprocessorCount, dev) != hipSuccess) { grid = -1; return; }
        if (hipFuncSetAttribute((const void*)mega_fwd, hipFuncAttributeMaxDynamicSharedMemorySize, LDS_BYTES) != hipSuccess) { fprintf(stderr, "kernel_launch: hipFuncSetAttribute failed\n"); grid = -1; return; }
        if (hipOccupancyMaxActiveBlocksPerMultiprocessor(&per_cu, (const void*)mega_fwd, NWAVES * 64, LDS_BYTES) != hipSuccess || per_cu < 1) { fprintf(stderr, "kernel_launch: occupancy query says %d\n", per_cu); per_cu = 1; }
        (void)hipGetLastError();
        grid = cus * per_cu;
    }
    if (grid < 0) return;
    if (hipMemsetAsync((char*)d_ws + WS_BAR, 0, BAR_BYTES, stream) != hipSuccess) { fprintf(stderr, "kernel_launch: hipMemsetAsync failed\n"); return; }
    Args a{};
    for (int i = 0; i < 21; ++i) a.in[i] = (const float*)d_in[i];
    a.out = (float*)d_out; a.ws = (unsigned char*)d_ws;
    void* params[] = {&a};
    hipError_t e = hipLaunchCooperativeKernel((const void*)mega_fwd, dim3(grid), dim3(NWAVES * 64), params, LDS_BYTES, stream);
    if (e != hipSuccess) fprintf(stderr, "kernel_launch: cooperative launch failed: %s (grid %d)\n", hipGetErrorString(e), grid);
}
```

```cpp
#include <hip/hip_runtime.h>
#include <hip/hip_cooperative_groups.h>
#include <hip/hip_bf16.h>
#include <cstdio>
#include <cstdint>
#include <cmath>
namespace pg8 {
#define PG8_LAS __attribute__((address_space(3)))
typedef unsigned short bf16_t;
typedef short bf16x8 __attribute__((ext_vector_type(8)));
typedef float f32x4 __attribute__((ext_vector_type(4)));
typedef unsigned u32x4 __attribute__((ext_vector_type(4)));
constexpr int BM = 256, BK = 64, HALF = 128, HTB = HALF * BK * 2  , STAGE_BYTES = 8 * HTB, NXCD = 8, WGM = 8;

__host__ __device__ __forceinline__ int lds_byte(int r, int c) { const int st = (r >> 4) * 2 + (c >> 5), rr = r & 15, cc = c & 31, ob = rr * 64 + cc * 2; return st * 1024 + (ob ^ (((ob >> 9) & 1) << 5)); }
__host__ __device__ __forceinline__ void stage_rc(int b, int& R, int& C) { const int st = b / 1024, sb = b % 1024, swz = sb ^ (((sb >> 9) & 1) << 5); R = (st >> 1) * 16 + swz / 64; C = (st & 1) * 32 + (swz % 64) / 2; }
__host__ __device__ __forceinline__ int perm32(int rho) { const int n = rho >> 4, i = rho & 15; return 8 * (i >> 2) + 4 * n + (i & 3); }

struct Unit { int pm, pn; };
struct Gemm { const bf16_t* A; const bf16_t* Bt; int M, N, K; long xa; };

struct StaticOrder {
    int nM, nN, nwg, G, c;
    __host__ __device__ void init(int M, int N, int G_, int c_) { nM = M / BM; nN = N / BM; nwg = nM * nN; G = G_; c = c_; }
    __host__ __device__ bool next(int i, Unit& u) const {
        const long L = (long)i * G + c; if (L >= nwg) return false;
        int wgid = (int)L; { const int q = nwg / NXCD, r = nwg % NXCD, xcd = wgid % NXCD, off = wgid / NXCD; wgid = (xcd < r ? xcd * (q + 1) : r * (q + 1) + (xcd - r) * q) + off; }
        const int nig = WGM * nN, gid = wgid / nig, fm = gid * WGM, gsz = (nM - fm) < WGM ? (nM - fm) : WGM;
        u.pm = fm + ((wgid % nig) % gsz); u.pn = (wgid % nig) / gsz; return true;
    }
    __device__ __forceinline__ void a_ready(const Unit&) const {}
    __device__ __forceinline__ void done(const Unit&) const {}
};
__device__ __forceinline__ unsigned cvt_pk_bf16(float lo, float hi) { unsigned r; asm volatile("v_cvt_pk_bf16_f32 %0, %1, %2" : "=v"(r) : "v"(lo), "v"(hi)); return r; }
typedef float f32x2 __attribute__((ext_vector_type(2)));
__device__ __forceinline__ float row_rs(const float* ssq, int row) { const f32x4 p = *(const f32x4*)(ssq + 4 * (size_t)row); return __builtin_amdgcn_rsqf(((p[0] + p[1]) + (p[2] + p[3])) * (1.0f / 1024.0f) + 1e-6f); }
typedef float f32x2 __attribute__((ext_vector_type(2)));
__device__ __forceinline__ f32x2 swiglu2(f32x2 g, f32x2 u, float nl, float rs2) {
    f32x2 t = g * nl; t.x = __builtin_fminf(t.x, 60.0f); t.y = __builtin_fminf(t.y, 60.0f);
    f32x2 d; d.x = __builtin_amdgcn_exp2f(t.x); d.y = __builtin_amdgcn_exp2f(t.y); d = d + 1.0f;
    const float r = __builtin_amdgcn_rcpf(d.x * d.y);
    const f32x2 ri = (f32x2){d.y, d.x} * r;
    return (g * u) * (ri * rs2);
}
struct EpiSwiGLU {
    static constexpr bool PERM = true, AFTER_DRAIN = false;
    bf16_t* O_; int ldc; const float* ssq; long xo;
    __device__ __forceinline__ void operator()(const f32x4 (&acc)[2][2][4][2], const Unit& u, int wr, int wc, int fr, int fq) const {
        bf16_t* O = O_ + (long)(u.pm >> 4) * xo;
        const int row0 = u.pm * BM + wr * 64 + fr, col0 = u.pn * HALF + wc * 32 + 8 * fq;
        float rsv[2][4];
#pragma unroll
        for (int ai = 0; ai < 2; ++ai)
#pragma unroll
            for (int m = 0; m < 4; ++m) rsv[ai][m] = row_rs(ssq, row0 + ai * HALF + m * 16);
#pragma unroll
        for (int ai = 0; ai < 2; ++ai)
#pragma unroll
            for (int m = 0; m < 4; ++m) { const int row = row0 + ai * HALF + m * 16; const float rs = rsv[ai][m], nl = -1.4426950408889634f * rs, rs2 = rs * rs;
                const f32x4 g0 = acc[ai][0][m][0], g1 = acc[ai][0][m][1], u0 = acc[ai][1][m][0], u1 = acc[ai][1][m][1];
                const f32x2 a = swiglu2((f32x2){g0[0], g0[1]}, (f32x2){u0[0], u0[1]}, nl, rs2), b = swiglu2((f32x2){g0[2], g0[3]}, (f32x2){u0[2], u0[3]}, nl, rs2);
                const f32x2 c = swiglu2((f32x2){g1[0], g1[1]}, (f32x2){u1[0], u1[1]}, nl, rs2), d = swiglu2((f32x2){g1[2], g1[3]}, (f32x2){u1[2], u1[3]}, nl, rs2);
                u32x4 w; w.x = cvt_pk_bf16(a.x, a.y); w.y = cvt_pk_bf16(b.x, b.y); w.z = cvt_pk_bf16(c.x, c.y); w.w = cvt_pk_bf16(d.x, d.y);
                *(u32x4*)(O + (size_t)row * ldc + col0) = w; }
    }
};
struct EpiRowScale {
    static constexpr bool PERM = true, AFTER_DRAIN = false;
    bf16_t* O_; int ldc; const float* ssq; long xo;
    __device__ __forceinline__ void operator()(const f32x4 (&acc)[2][2][4][2], const Unit& u, int wr, int wc, int fr, int fq) const {
        bf16_t* O = O_ + (long)(u.pm >> 4) * xo;
        const int row0 = u.pm * BM + wr * 64 + fr, col0 = u.pn * BM + wc * 32 + 8 * fq;
        float rsv[2][4];
#pragma unroll
        for (int ai = 0; ai < 2; ++ai)
#pragma unroll
            for (int m = 0; m < 4; ++m) rsv[ai][m] = row_rs(ssq, row0 + ai * HALF + m * 16);
#pragma unroll
        for (int ai = 0; ai < 2; ++ai)
#pragma unroll
            for (int m = 0; m < 4; ++m) { const int row = row0 + ai * HALF + m * 16; const float rs = rsv[ai][m]; bf16_t* rowp = O + (size_t)row * ldc + col0;
#pragma unroll
                for (int bj = 0; bj < 2; ++bj) { const f32x4 v0 = acc[ai][bj][m][0] * rs, v1 = acc[ai][bj][m][1] * rs;
                    u32x4 w; w.x = cvt_pk_bf16(v0[0], v0[1]); w.y = cvt_pk_bf16(v0[2], v0[3]); w.z = cvt_pk_bf16(v1[0], v1[1]); w.w = cvt_pk_bf16(v1[2], v1[3]);
                    *(u32x4*)(rowp + bj * HALF) = w; } }
    }
};
struct EpiResid {
    static constexpr bool PERM = true, AFTER_DRAIN = false;
    bf16_t* xb; float* ssq_out; float alpha;
    __device__ __forceinline__ void operator()(const f32x4 (&acc)[2][2][4][2], const Unit& u, int wr, int wc, int fr, int fq) const {
        PG8_LAS float* P = (PG8_LAS float*)(STAGE_BYTES);
        const int row0 = u.pm * BM + wr * 64 + fr, col0 = u.pn * BM + wc * 32 + 8 * fq;
        bf16_t* tile = xb + (size_t)row0 * 1024 + col0;
        u32x4 bv[2][4][2];
#pragma unroll
        for (int ai = 0; ai < 2; ++ai)
#pragma unroll
            for (int m = 0; m < 4; ++m)
#pragma unroll
                for (int bj = 0; bj < 2; ++bj) bv[ai][m][bj] = *(const u32x4*)(tile + (size_t)(ai * HALF + m * 16) * 1024 + bj * HALF);
#pragma unroll
        for (int ai = 0; ai < 2; ++ai)
#pragma unroll
            for (int m = 0; m < 4; ++m) { bf16_t* rowp = tile + (size_t)(ai * HALF + m * 16) * 1024; float s = 0.f;
#pragma unroll
                for (int bj = 0; bj < 2; ++bj) { const u32x4 b = bv[ai][m][bj];
                    const f32x4 b0 = {__builtin_bit_cast(float, b.x << 16), __builtin_bit_cast(float, b.x & 0xffff0000u), __builtin_bit_cast(float, b.y << 16), __builtin_bit_cast(float, b.y & 0xffff0000u)};
                    const f32x4 b1 = {__builtin_bit_cast(float, b.z << 16), __builtin_bit_cast(float, b.z & 0xffff0000u), __builtin_bit_cast(float, b.w << 16), __builtin_bit_cast(float, b.w & 0xffff0000u)};
                    const f32x4 o0 = b0 + acc[ai][bj][m][0] * alpha, o1 = b1 + acc[ai][bj][m][1] * alpha;
                    s += ((o0[0] * o0[0] + o0[1] * o0[1]) + (o0[2] * o0[2] + o0[3] * o0[3])) + ((o1[0] * o1[0] + o1[1] * o1[1]) + (o1[2] * o1[2] + o1[3] * o1[3]));
                    u32x4 w; w.x = cvt_pk_bf16(o0[0], o0[1]); w.y = cvt_pk_bf16(o0[2], o0[3]); w.z = cvt_pk_bf16(o1[0], o1[1]); w.w = cvt_pk_bf16(o1[2], o1[3]);
                    *(u32x4*)(rowp + bj * HALF) = w; }
                s += __shfl_xor(s, 16); s += __shfl_xor(s, 32);
                if (fq == 0) P[(ai * HALF + wr * 64 + m * 16 + fr) * 4 + wc] = s; }
        asm volatile("s_waitcnt lgkmcnt(0)" ::: "memory"); __builtin_amdgcn_s_barrier(); asm volatile("" ::: "memory");
        int t = threadIdx.x; asm volatile("" : "+v"(t));
        if (t < 256) { const f32x4 p = *(const PG8_LAS f32x4*)(P + 4 * t); ssq_out[(size_t)(u.pm * BM + t) * 4 + u.pn] = (p[0] + p[1]) + (p[2] + p[3]); }
    }
};

template <class Epi, class Sched, bool ALIGN_EPI = false, bool SP2 = false>
__device__ __forceinline__ void gemm_phase(PG8_LAS unsigned char* lds, const Gemm g, const Sched& S, const Epi& E) {
    int tid_ = threadIdx.x; asm volatile("" : "+v"(tid_));
    const int tid = tid_, wid = __builtin_amdgcn_readfirstlane(tid >> 6), lane = tid & 63, wr = wid >> 2, wc = wid & 3, fr = lane & 15, fq = lane >> 4;
    const int K = g.K, nt = K / BK;
    unsigned voffA[2], voffB[2];
#pragma unroll
    for (int i = 0; i < 2; ++i) { int R, C; stage_rc(tid * 16 + i * 8192, R, C); const int Rb = Epi::PERM ? ((R & ~31) + perm32(R & 31)) : R;
        voffA[i] = (unsigned)(R * K + C) * 2u; voffB[i] = (unsigned)(Rb * K + C) * 2u; }
    const size_t kstep = (size_t)(BK * 2);
    const size_t hstep = (size_t)HALF * K * 2;
    const size_t tstep = 2 * hstep;
    const unsigned ldsw = (unsigned)wid * 1024u;
    const int aoff = lds_byte(wr * 64 + fr, fq * 8), boff = lds_byte(wc * 32 + fr, fq * 8);
#define PG8_SA(b, h) (((b) * 2 + (h)) * HTB)
#define PG8_SB(b, h) ((4 + (b) * 2 + (h)) * HTB)
#define PG8_STAGE(bufoff, gbase, voff) do { _Pragma("unroll") for (int _i = 0; _i < 2; ++_i) \
        __builtin_amdgcn_global_load_lds((const unsigned*)((const char*)(gbase) + (voff)[_i]), (PG8_LAS unsigned*)(lds + (bufoff) + ldsw + _i * 8192), 16, 0, 0); } while (0)
#define PG8_LDA(dst, b, h) do { _Pragma("unroll") for (int m = 0; m < 4; ++m) _Pragma("unroll") for (int k = 0; k < 2; ++k) dst[m][k] = *(const PG8_LAS bf16x8*)(lds + PG8_SA(b, h) + aoff + m * 2048 + k * 1024); } while (0)
#define PG8_LDB(dst, b, h) do { _Pragma("unroll") for (int n = 0; n < 2; ++n) _Pragma("unroll") for (int k = 0; k < 2; ++k) dst[n][k] = *(const PG8_LAS bf16x8*)(lds + PG8_SB(b, h) + boff + n * 2048 + k * 1024); } while (0)
#define PG8_MMA(ai, bj, At, Bt) do { __builtin_amdgcn_s_setprio(1); _Pragma("unroll") for (int m = 0; m < 4; ++m) _Pragma("unroll") for (int n = 0; n < 2; ++n) _Pragma("unroll") for (int k = 0; k < 2; ++k) \
        acc[ai][bj][m][n] = __builtin_amdgcn_mfma_f32_16x16x32_bf16(Bt[n][k], At[m][k], acc[ai][bj][m][n], 0, 0, 0); __builtin_amdgcn_s_setprio(0); } while (0)
#define PG8_WAIT_V(n) asm volatile("s_waitcnt vmcnt(" #n ")" ::: "memory")
#define PG8_WAIT_L(n) asm volatile("s_waitcnt lgkmcnt(" #n ")" ::: "memory")
#define PG8_BAR __builtin_amdgcn_s_barrier()
#define PG8_SCHED __builtin_amdgcn_sched_barrier(0)
    Unit cur, nxt; int ui = 0;
    if (!S.next(0, cur)) return;
    f32x4 acc[2][2][4][2];
#pragma unroll
    for (int a = 0; a < 2; ++a)
#pragma unroll
        for (int b = 0; b < 2; ++b)
#pragma unroll
            for (int m = 0; m < 4; ++m)
#pragma unroll
                for (int n = 0; n < 2; ++n) acc[a][b][m][n] = (f32x4){0.f, 0.f, 0.f, 0.f};
    bf16x8 At[4][2], B0[2][2], B1[2][2];
    const char* cA = (const char*)g.A + (size_t)cur.pm * tstep + (long)(cur.pm >> 4) * g.xa; const char* cB = (const char*)g.Bt + (size_t)cur.pn * tstep;
    S.a_ready(cur);
    if constexpr (SP2) {
        PG8_STAGE(PG8_SB(0, 0), cB, voffB); PG8_STAGE(PG8_SB(0, 1), cB + hstep, voffB); PG8_STAGE(PG8_SA(0, 0), cA, voffA); PG8_STAGE(PG8_SA(0, 1), cA + hstep, voffA);
        if (wr == 1) PG8_BAR;
        PG8_WAIT_V(2); PG8_BAR;
        PG8_STAGE(PG8_SB(1, 0), cB + kstep, voffB); PG8_STAGE(PG8_SA(1, 0), cA + kstep, voffA); PG8_STAGE(PG8_SB(1, 1), cB + hstep + kstep, voffB);
        PG8_WAIT_V(6); PG8_BAR;
    } else {
        PG8_STAGE(PG8_SB(0, 0), cB, voffB); PG8_STAGE(PG8_SA(0, 0), cA, voffA); PG8_STAGE(PG8_SB(0, 1), cB + hstep, voffB); PG8_STAGE(PG8_SA(0, 1), cA + hstep, voffA);
        if (wr == 1) PG8_BAR;
        PG8_WAIT_V(4); PG8_BAR;
        PG8_STAGE(PG8_SB(1, 0), cB + kstep, voffB); PG8_STAGE(PG8_SA(1, 0), cA + kstep, voffA); PG8_STAGE(PG8_SB(1, 1), cB + hstep + kstep, voffB);
        PG8_WAIT_V(6); PG8_BAR;
    }
    for (;;) {
        const bool has_next = S.next(ui + 1, nxt);
        const char* nA = has_next ? (const char*)g.A + (size_t)nxt.pm * tstep + (long)(nxt.pm >> 4) * g.xa : cA; const char* nB = has_next ? (const char*)g.Bt + (size_t)nxt.pn * tstep : cB;
        for (int t = 0; t < nt; t += 2) {
            const bool last = (t == nt - 2);
            const char* a1 = cA + (size_t)(t + 1) * kstep;
            const char* a2 = last ? nA : cA + (size_t)(t + 2) * kstep; const char* b2 = last ? nB : cB + (size_t)(t + 2) * kstep;
            const char* a3 = a2 + kstep; const char* b3 = b2 + kstep;
            if (last && has_next) S.a_ready(nxt);
            if constexpr (SP2) {
            PG8_LDB(B0, 0, 0); PG8_LDB(B1, 0, 1); PG8_SCHED; PG8_LDA(At, 0, 0); PG8_STAGE(PG8_SA(1, 1), a1 + hstep, voffA);
            PG8_WAIT_V(8); PG8_WAIT_L(0); PG8_BAR; PG8_MMA(0, 0, At, B0); PG8_MMA(0, 1, At, B1); PG8_BAR; PG8_SCHED;
            PG8_LDA(At, 0, 1); PG8_STAGE(PG8_SB(0, 0), b2, voffB); PG8_STAGE(PG8_SB(0, 1), b2 + hstep, voffB); PG8_STAGE(PG8_SA(0, 0), a2, voffA);
            PG8_WAIT_V(8); PG8_WAIT_L(0); PG8_BAR; PG8_MMA(1, 0, At, B0); PG8_MMA(1, 1, At, B1); PG8_BAR; PG8_SCHED;
            PG8_LDB(B0, 1, 0); PG8_LDB(B1, 1, 1); PG8_SCHED; PG8_LDA(At, 1, 0); PG8_STAGE(PG8_SA(0, 1), a2 + hstep, voffA);
            PG8_WAIT_V(8); PG8_WAIT_L(0); PG8_BAR; PG8_MMA(0, 0, At, B0); PG8_MMA(0, 1, At, B1); PG8_BAR; PG8_SCHED;
            PG8_LDA(At, 1, 1); PG8_STAGE(PG8_SB(1, 0), b3, voffB); PG8_STAGE(PG8_SB(1, 1), b3 + hstep, voffB); PG8_STAGE(PG8_SA(1, 0), a3, voffA);
            PG8_WAIT_V(8); PG8_WAIT_L(0); PG8_BAR; PG8_MMA(1, 0, At, B0); PG8_MMA(1, 1, At, B1); PG8_BAR; PG8_SCHED;
            } else {
            PG8_LDB(B0, 0, 0); PG8_SCHED; PG8_LDA(At, 0, 0); PG8_STAGE(PG8_SA(1, 1), a1 + hstep, voffA);
            PG8_WAIT_L(8); PG8_BAR; PG8_WAIT_L(0); PG8_MMA(0, 0, At, B0); PG8_BAR; PG8_SCHED;
            PG8_LDB(B1, 0, 1); PG8_STAGE(PG8_SB(0, 0), b2, voffB);
            PG8_BAR; PG8_WAIT_L(0); PG8_MMA(0, 1, At, B1); PG8_BAR;
            PG8_LDA(At, 0, 1); PG8_STAGE(PG8_SA(0, 0), a2, voffA);
            PG8_BAR; PG8_WAIT_L(0); PG8_MMA(1, 0, At, B0); PG8_BAR; PG8_SCHED;
            PG8_STAGE(PG8_SB(0, 1), b2 + hstep, voffB);
            PG8_WAIT_V(6); PG8_BAR; PG8_MMA(1, 1, At, B1); PG8_BAR;
            PG8_LDB(B0, 1, 0); PG8_SCHED; PG8_LDA(At, 1, 0); PG8_STAGE(PG8_SA(0, 1), a2 + hstep, voffA);
            PG8_WAIT_L(8); PG8_BAR; PG8_WAIT_L(0); PG8_MMA(0, 0, At, B0); PG8_BAR; PG8_SCHED;
            PG8_LDB(B1, 1, 1); PG8_STAGE(PG8_SB(1, 0), b3, voffB);
            PG8_BAR; PG8_WAIT_L(0); PG8_MMA(0, 1, At, B1); PG8_BAR;
            PG8_LDA(At, 1, 1); PG8_STAGE(PG8_SA(1, 0), a3, voffA);
            PG8_BAR; PG8_WAIT_L(0); PG8_MMA(1, 0, At, B0); PG8_BAR; PG8_SCHED;
            PG8_STAGE(PG8_SB(1, 1), b3 + hstep, voffB);
            PG8_WAIT_V(6); PG8_BAR; PG8_MMA(1, 1, At, B1); PG8_BAR;
            }
        }
        if constexpr (ALIGN_EPI) { if (wr == 0) PG8_BAR; }
        if constexpr (!Epi::AFTER_DRAIN) { E(acc, cur, wr, wc, fr, fq); S.done(cur); }
        if (!has_next) break;
#pragma unroll
        for (int a = 0; a < 2; ++a)
#pragma unroll
            for (int b = 0; b < 2; ++b)
#pragma unroll
                for (int m = 0; m < 4; ++m)
#pragma unroll
                    for (int n = 0; n < 2; ++n) acc[a][b][m][n] = (f32x4){0.f, 0.f, 0.f, 0.f};
        cur = nxt; cA = nA; cB = nB; ++ui;
        if constexpr (ALIGN_EPI) { if (wr == 1) PG8_BAR; }
    }
    PG8_WAIT_V(0);
    if constexpr (!ALIGN_EPI) { if (wr == 0) PG8_BAR; }
    PG8_BAR;
    if constexpr (Epi::AFTER_DRAIN) { E.fused(acc, cur, wr, wc, fr, fq, lds, wid, lane); S.done(cur); }
#undef PG8_SA
#undef PG8_SB
#undef PG8_STAGE
#undef PG8_LDA
#undef PG8_LDB
#undef PG8_MMA
#undef PG8_WAIT_V
#undef PG8_WAIT_L
#undef PG8_BAR
#undef PG8_SCHED
}
}
namespace attn_body {
using bf16=__hip_bfloat16;
using bf16x8=__attribute__((ext_vector_type(8)))short;
using s16x4=__attribute__((ext_vector_type(4)))short;
using f32x16=__attribute__((ext_vector_type(16)))float;
using u32x4=__attribute__((ext_vector_type(4)))unsigned;
constexpr int BATCH=16,NHEAD=8,SEQ=2048,D=64,PQ=2304,PO=1024;
constexpr int NW=8,QBLK=32,QB=QBLK*NW,KVBLK=64,NQB=SEQ/QB;
constexpr int ATTN_UNIT_ROWS=QB;
__device__ __forceinline__ int crow(int r,int hi){return (r&3)+8*(r>>2)+4*hi;}
#define SBAR() __builtin_amdgcn_sched_barrier(0)
__device__ __forceinline__ void cmask(f32x16&p0,f32x16&p1,int jb,int qrel,int hi){
  const float NEG=-INFINITY; int kb=64*jb+4*hi;
  #pragma unroll
  for(int r=0;r<16;++r){int kv=kb+(r&3)+8*(r>>2); if(kv>qrel)p0[r]=NEG; if(kv+32>qrel)p1[r]=NEG;}
}

constexpr int NSLOT=3, SLOTB=8192;
constexpr int LDS_K=0, LDS_V=NSLOT*SLOTB, LDS_WS=2*NSLOT*SLOTB, LDS_OST=LDS_WS+NW*64*4, LDS_BYTES=LDS_OST+NW*4096;
constexpr float C2=0.125f*1.4426950408889634f;
__device__ __forceinline__ void glds16(const void*gsrc,unsigned lds_dst){unsigned keep;
  asm volatile("s_mov_b32 %0, m0\n\ts_mov_b32 m0, %2\n\ts_nop 0\n\tglobal_load_lds_dwordx4 %1, off\n\ts_mov_b32 m0, %0":"=&s"(keep):"v"(gsrc),"s"(lds_dst):"memory");}
__device__ __forceinline__ float max3f(float a,float b,float c){float r;asm("v_max3_f32 %0, %1, %2, %3":"=v"(r):"v"(a),"v"(b),"v"(c));return r;}
__device__ __forceinline__ float max2f(float a,float b){float r;asm("v_max_f32_e32 %0, %1, %2":"=v"(r):"v"(a),"v"(b));return r;}
__device__ __forceinline__ float fadd_s(float a,float b){float r;asm("v_add_f32_e32 %0, %1, %2":"=v"(r):"v"(a),"v"(b));return r;}
__device__ __forceinline__ float fsub_s(float a,float b){float r;asm("v_sub_f32_e32 %0, %1, %2":"=v"(r):"v"(a),"v"(b));return r;}
typedef float f32x2_t __attribute__((ext_vector_type(2))); typedef __bf16 bf16x2_t __attribute__((ext_vector_type(2)));
__device__ __forceinline__ unsigned cvtpk_s(float lo,float hi){f32x2_t v={lo,hi};bf16x2_t b=__builtin_convertvector(v,bf16x2_t);return __builtin_bit_cast(unsigned,b);}
#define WAIT_BAR(N) asm volatile("s_waitcnt vmcnt(" #N ") lgkmcnt(0)\n\ts_barrier":::"memory")

__device__ __forceinline__ void qkt(f32x16&p0,f32x16&p1,const char*Kslot,const bf16x8*qr,const f32x16&negm,int r32,int hi){
  const char*kb=Kslot+hi*1024+r32*16;
  #pragma unroll
  for(int d0=0;d0<4;++d0){
    const bf16x8 b0=*reinterpret_cast<const bf16x8*>(kb+d0*2048);
    const bf16x8 b1=*reinterpret_cast<const bf16x8*>(kb+d0*2048+512);
    if(d0==0){p0=__builtin_amdgcn_mfma_f32_32x32x16_bf16(b0,qr[0],negm,0,0,0);p1=__builtin_amdgcn_mfma_f32_32x32x16_bf16(b1,qr[0],negm,0,0,0);}
    else{p0=__builtin_amdgcn_mfma_f32_32x32x16_bf16(b0,qr[d0],p0,0,0,0);p1=__builtin_amdgcn_mfma_f32_32x32x16_bf16(b1,qr[d0],p1,0,0,0);}}
}
typedef __attribute__((address_space(3))) const char* lds_cptr;
typedef short v4i16_t __attribute__((ext_vector_type(4)));
__device__ __forceinline__ void kload8(bf16x8*kf,lds_cptr kp){
  kf[0]=*(const __attribute__((address_space(3))) bf16x8*)(kp);      kf[1]=*(const __attribute__((address_space(3))) bf16x8*)(kp+512);
  kf[2]=*(const __attribute__((address_space(3))) bf16x8*)(kp+2048); kf[3]=*(const __attribute__((address_space(3))) bf16x8*)(kp+2560);
  kf[4]=*(const __attribute__((address_space(3))) bf16x8*)(kp+4096); kf[5]=*(const __attribute__((address_space(3))) bf16x8*)(kp+4608);
  kf[6]=*(const __attribute__((address_space(3))) bf16x8*)(kp+6144); kf[7]=*(const __attribute__((address_space(3))) bf16x8*)(kp+6656);
}
__device__ __forceinline__ void kload2(bf16x8*kf,lds_cptr kp,int j){ kf[2*j]=*(const __attribute__((address_space(3))) bf16x8*)(kp+j*2048); kf[2*j+1]=*(const __attribute__((address_space(3))) bf16x8*)(kp+j*2048+512); }
__device__ __forceinline__ s16x4 vtr(lds_cptr p){ return __builtin_bit_cast(s16x4,__builtin_amdgcn_ds_read_tr16_b64_v4i16((__attribute__((address_space(3))) v4i16_t*)p)); }
__device__ __forceinline__ float rowmax(const f32x16&p0,const f32x16&p1){
  float a=max3f(p0[0],p0[1],p1[0]),b=max3f(p0[2],p0[3],p1[1]);a=max3f(a,p1[2],p1[3]);
  #pragma unroll
  for(int r=4;r<16;r+=4){a=max3f(a,p0[r],p0[r+1]);b=max3f(b,p0[r+2],p0[r+3]);a=max3f(a,p1[r],p1[r+1]);b=max3f(b,p1[r+2],p1[r+3]);}
  const float m=max2f(a,b);
  auto rr=__builtin_amdgcn_permlane32_swap(__float_as_uint(m),__float_as_uint(m),false,false);
  return max2f(__uint_as_float(rr[0]),__uint_as_float(rr[1]));
}
__device__ __forceinline__ void pv(f32x16*o,int vb,bf16x8 pa0,bf16x8 pa1,bf16x8 pa2,bf16x8 pa3){
  #pragma unroll
  for(int d0=0;d0<2;++d0){s16x4 lo[4],hi[4];
    #pragma unroll
    for(int ks=0;ks<4;++ks){
      asm volatile("ds_read_b64_tr_b16 %0,%1 offset:%c2":"=&v"(lo[ks]):"v"(vb),"i"(d0*4096+ks*1024):"memory");
      asm volatile("ds_read_b64_tr_b16 %0,%1 offset:%c2":"=&v"(hi[ks]):"v"(vb),"i"(d0*4096+ks*1024+512):"memory");}
    asm volatile("s_waitcnt lgkmcnt(0)":::"memory");SBAR();
    #define PK(k) (bf16x8){lo[k][0],lo[k][1],lo[k][2],lo[k][3],hi[k][0],hi[k][1],hi[k][2],hi[k][3]}
    o[d0]=__builtin_amdgcn_mfma_f32_32x32x16_bf16(pa0,PK(0),o[d0],0,0,0);
    o[d0]=__builtin_amdgcn_mfma_f32_32x32x16_bf16(pa1,PK(1),o[d0],0,0,0);
    o[d0]=__builtin_amdgcn_mfma_f32_32x32x16_bf16(pa2,PK(2),o[d0],0,0,0);
    o[d0]=__builtin_amdgcn_mfma_f32_32x32x16_bf16(pa3,PK(3),o[d0],0,0,0);
    #undef PK
  }
}

#ifndef ATTN_STORE16
#define ATTN_STORE16(p,v) (*(u32x4*)(p)=(v))
#endif
template<int THRL> __device__ __forceinline__ void attn_unit(int b,int qb,const bf16*Q,const bf16*__restrict__ K,const bf16*__restrict__ V,bf16*O,char*shm){
  int tid_=threadIdx.x; asm volatile("":"+v"(tid_)); const int tid=tid_,lane=tid&63,r32=lane&31,hi=lane>>5; const int wid=__builtin_amdgcn_readfirstlane(tid>>6);
  const long rowbase=(long)b*SEQ; const int q0=qb*QB;
  const bf16*Qw=Q+(rowbase+q0+wid*QBLK)*PQ;
  const bf16*Kh=K+rowbase*PQ,*Vh=V+rowbase*PQ;
  const unsigned lds0=(unsigned)(uintptr_t)shm;
  float*wsf=(float*)(shm+LDS_WS)+wid*64;
  const bf16*ksrc=Kh+(long)lane*PQ+wid*8;
  const bf16*vsrc=Vh+(long)(16*(wid&3)+(lane>>2))*PQ+(wid>>2)*32+(lane&3)*8;
  const unsigned kdst=lds0+LDS_K+wid*1024, vdst=lds0+LDS_V+wid*1024;
  #define DMA_K(t,slot) glds16(ksrc+(long)(t)*KVBLK*PQ,(unsigned)__builtin_amdgcn_readfirstlane(kdst+(slot)))
  #define DMA_V(t,slot) glds16(vsrc+(long)(t)*KVBLK*PQ,(unsigned)__builtin_amdgcn_readfirstlane(vdst+(slot)))
  const int vb0=(int)(lds0+LDS_V)+((lane>>4)&1)*32+(lane&3)*8+(4*hi+((lane&15)>>2))*64;
  const char*Kbase=shm+LDS_K; bf16x8 kf[8];
  const lds_cptr shm3=(lds_cptr)shm; const lds_cptr kp0=shm3+LDS_K+hi*1024+r32*16; const lds_cptr vp0=shm3+LDS_V+((lane>>4)&1)*32+(lane&3)*8+(4*hi+((lane&15)>>2))*64;
  int NT=SEQ/KVBLK; asm volatile("":"+s"(NT));
  DMA_K(0,0);DMA_V(0,0);DMA_K(1,SLOTB);
  bf16x8 qr[4];
  #pragma unroll
  for(int d0=0;d0<4;++d0)qr[d0]=*reinterpret_cast<const bf16x8*>(&Qw[(long)r32*PQ+d0*16+hi*8]);
  float mhat=0.f,l_reg=0.f;f32x16 o[2];o[0]=f32x16{};o[1]=f32x16{};f32x16 negm=f32x16{};asm volatile("":"+v"(negm));
    #define CMASK(P0,P1,t) do{}while(0)
  bool resc=false;
  #define START(P0,P1) do{ const float rm=rowmax(P0,P1); resc=false; \
    { const float dl=rm; mhat=fadd_s(mhat,dl); \
      _Pragma("unroll") for(int r=0;r<16;++r){P0[r]=fsub_s(P0[r],dl);P1[r]=fsub_s(P1[r],dl);} \
      _Pragma("unroll") for(int r=0;r<16;++r)negm[r]=-mhat; asm volatile("":"+v"(negm)); } \
    _Pragma("unroll") for(int r=0;r<16;++r)P0[r]=__builtin_amdgcn_exp2f(P0[r]); }while(0)
  #define RESC() do{ if(resc){ asm volatile("s_waitcnt lgkmcnt(0)":::"memory"); \
      _Pragma("unroll") for(int d_=0;d_<2;++d_) _Pragma("unroll") for(int r=0;r<16;++r)o[d_][r]*=wsf[crow(r,hi)]; } }while(0)
  f32x16 pA0,pA1,pB0,pB1;
  int sl_prev=0,sl_cur=0,sl_next=SLOTB;
  #define ROT() do{sl_prev=sl_cur;sl_cur=sl_next;sl_next=(sl_next==(NSLOT-1)*SLOTB)?0:sl_next+SLOTB;}while(0)
  DMA_K(2,2*SLOTB);
  WAIT_BAR(3);
  qkt(pA0,pA1,Kbase,qr,negm,r32,hi);asm volatile("s_nop 15\n\ts_nop 7":"+v"(pA0),"+v"(pA1));CMASK(pA0,pA1,0);
  START(pA0,pA1);
  _Pragma("unroll") for(int r=0;r<16;++r)pA1[r]=__builtin_amdgcn_exp2f(pA1[r]);
  WAIT_BAR(0);
  DMA_K(3,0);DMA_V(1,SLOTB);
  ROT();
  kload8(kf,kp0+sl_cur);
  WAIT_BAR(2);
  s16x4 vlo[8],vhi[8]; u32x4 pw0,pw1,pw2,pw3;
  #define PKW(P,B) cvtpk_s(P[B],P[B+1])
  #define PAF(k) __builtin_bit_cast(bf16x8,pw##k)
  #define VFR(i) (bf16x8){vlo[i][0],vlo[i][1],vlo[i][2],vlo[i][3],vhi[i][0],vhi[i][1],vhi[i][2],vhi[i][3]}
  #define PIN(x) asm volatile("":"+v"(x))
  #define MX3(a,b,c) __builtin_fmaxf(__builtin_fmaxf((a),(b)),(c))
  #define GAPA(MF,A0,A1,A2,A3,W0,W1,PW) do{ MF; sacc+=A0; sacc+=A1; sacc+=A2; sacc+=A3; PIN(sacc); W0; W1; PIN(PW); SBAR(); }while(0)
  #define EX(v) __builtin_amdgcn_exp2f(v)
  #define GAPB(MF,X,B) do{ MF; X[B]=EX(X[B]); X[B+1]=EX(X[B+1]); X[B+2]=EX(X[B+2]); X[B+3]=EX(X[B+3]); PIN(X); SBAR(); }while(0)
  #define VRD(i) do{ vlo[i]=vtr(vp_+(((i)>>2)*4096+((i)&3)*1024)); vhi[i]=vtr(vp_+(((i)>>2)*4096+((i)&3)*1024+512)); }while(0)
  #define KRD(G,j) do{ if(G){ kload2(kf,kp0+sl_next,j); SBAR(); } }while(0)
  #define STEP(C0,C1,P0,P1,t,GK,GV,GL) do{ SBAR(); \
    const lds_cptr vp_=vp0+sl_prev; \
    VRD(0); SBAR(); float sacc=(P0[0]+P0[1]); \
    GAPA(C0=__builtin_amdgcn_mfma_f32_32x32x16_bf16(kf[0],qr[0],negm,0,0,0), P0[2],P0[3],P0[4],P0[5],     pw0[0]=PKW(P0,0), pw0[1]=PKW(P0,2), pw0); \
    VRD(4); SBAR(); GAPA(C1=__builtin_amdgcn_mfma_f32_32x32x16_bf16(kf[1],qr[0],negm,0,0,0), P0[6],P0[7],P0[8],P0[9],     pw0[2]=PKW(P0,4), pw0[3]=PKW(P0,6), pw0); \
    VRD(1); SBAR(); GAPA(C0=__builtin_amdgcn_mfma_f32_32x32x16_bf16(kf[2],qr[1],C0,0,0,0),   P0[10],P0[11],P0[12],P0[13], pw1[0]=PKW(P0,8), pw1[1]=PKW(P0,10), pw1); \
    VRD(5); SBAR(); GAPA(C1=__builtin_amdgcn_mfma_f32_32x32x16_bf16(kf[3],qr[1],C1,0,0,0),   P0[14],P0[15],P1[0],P1[1],   pw1[2]=PKW(P0,12),pw1[3]=PKW(P0,14), pw1); \
    VRD(2); SBAR(); GAPA(C0=__builtin_amdgcn_mfma_f32_32x32x16_bf16(kf[4],qr[2],C0,0,0,0),   P1[2],P1[3],P1[4],P1[5],     pw2[0]=PKW(P1,0), pw2[1]=PKW(P1,2), pw2); \
    VRD(6); SBAR(); GAPA(C1=__builtin_amdgcn_mfma_f32_32x32x16_bf16(kf[5],qr[2],C1,0,0,0),   P1[6],P1[7],P1[8],P1[9],     pw2[2]=PKW(P1,4), pw2[3]=PKW(P1,6), pw2); \
    VRD(3); SBAR(); GAPA(C0=__builtin_amdgcn_mfma_f32_32x32x16_bf16(kf[6],qr[3],C0,0,0,0),   P1[10],P1[11],P1[12],P1[13], pw3[0]=PKW(P1,8), pw3[1]=PKW(P1,10), pw3); \
    VRD(7); SBAR(); GAPA(C1=__builtin_amdgcn_mfma_f32_32x32x16_bf16(kf[7],qr[3],C1,0,0,0),   P1[14],P1[15],0.f,0.f,       pw3[2]=PKW(P1,12),pw3[3]=PKW(P1,14), pw3); \
    l_reg+=sacc; \
    if(GK){DMA_K((t)+3,sl_cur);} if(GV){DMA_V((t)+1,sl_next);} \
    CMASK(C0,C1,t); \
    { float a=MX3(C0[0],C0[1],C1[0]),b=MX3(C0[2],C0[3],C1[1]); a=MX3(a,C1[2],C1[3]); \
      _Pragma("unroll") for(int r=4;r<16;r+=4){a=MX3(a,C0[r],C0[r+1]);b=MX3(b,C0[r+2],C0[r+3]);a=MX3(a,C1[r],C1[r+1]);b=MX3(b,C1[r+2],C1[r+3]);} \
      float rm=__builtin_fmaxf(a,b); { auto rr=__builtin_amdgcn_permlane32_swap(__float_as_uint(rm),__float_as_uint(rm),false,false); rm=__builtin_fmaxf(__uint_as_float(rr[0]),__uint_as_float(rr[1])); } \
      resc=false; \
      if(__builtin_expect(__any(rm>(float)THRL),0)){ const float dl=__builtin_fmaxf(rm,0.f); mhat+=dl; \
        _Pragma("unroll") for(int r=0;r<16;++r){C0[r]-=dl;C1[r]-=dl;} \
        _Pragma("unroll") for(int r=0;r<16;++r)negm[r]=-mhat; asm volatile("":"+v"(negm)); \
        const float f=__builtin_amdgcn_exp2f(-dl); l_reg*=f; if(hi==0)wsf[r32]=f; resc=true; } } \
    SBAR(); \
    GAPB(o[0]=__builtin_amdgcn_mfma_f32_32x32x16_bf16(PAF(0),VFR(0),o[0],0,0,0), C0,0); \
    GAPB(o[1]=__builtin_amdgcn_mfma_f32_32x32x16_bf16(PAF(0),VFR(4),o[1],0,0,0), C0,4); \
    KRD(GL,0); GAPB(o[0]=__builtin_amdgcn_mfma_f32_32x32x16_bf16(PAF(1),VFR(1),o[0],0,0,0), C0,8); \
    KRD(GL,1); GAPB(o[1]=__builtin_amdgcn_mfma_f32_32x32x16_bf16(PAF(1),VFR(5),o[1],0,0,0), C0,12); \
    KRD(GL,2); GAPB(o[0]=__builtin_amdgcn_mfma_f32_32x32x16_bf16(PAF(2),VFR(2),o[0],0,0,0), C1,0); \
    KRD(GL,3); GAPB(o[1]=__builtin_amdgcn_mfma_f32_32x32x16_bf16(PAF(2),VFR(6),o[1],0,0,0), C1,4); \
    GAPB(o[0]=__builtin_amdgcn_mfma_f32_32x32x16_bf16(PAF(3),VFR(3),o[0],0,0,0), C1,8); \
    GAPB(o[1]=__builtin_amdgcn_mfma_f32_32x32x16_bf16(PAF(3),VFR(7),o[1],0,0,0), C1,12); \
    }while(0)
  int t=1;
  #undef CMASK
  #define CMASK(P0,P1,t) do{}while(0)
  for(;t+5<NT;t+=2){
    STEP(pB0,pB1,pA0,pA1,t,true,true,true);     WAIT_BAR(2); RESC(); ROT();
    STEP(pA0,pA1,pB0,pB1,t+1,true,true,true);   WAIT_BAR(2); RESC(); ROT();
  }
  #undef CMASK
  #define CMASK(P0,P1,t) do{}while(0)
  #define ENDW(tt) do{ if((tt)+3<NT){WAIT_BAR(2);} else if((tt)+2<NT){WAIT_BAR(1);} else {WAIT_BAR(0);} }while(0)
  for(;t+1<NT;t+=2){
    STEP(pB0,pB1,pA0,pA1,t,(t+3<NT),(t+1<NT),(t+1<NT));       ENDW(t);   RESC(); ROT();
    STEP(pA0,pA1,pB0,pB1,t+1,(t+4<NT),(t+2<NT),(t+2<NT));     ENDW(t+1); RESC(); ROT();
  }
  STEP(pB0,pB1,pA0,pA1,NT-1,false,false,false); RESC();
  { float sacc=pB0[0]+pB0[1]; _Pragma("unroll") for(int r=2;r<16;++r)sacc+=pB0[r]; _Pragma("unroll") for(int r=0;r<16;++r)sacc+=pB1[r]; l_reg+=sacc;
    pw0=(u32x4){PKW(pB0,0),PKW(pB0,2),PKW(pB0,4),PKW(pB0,6)};pw1=(u32x4){PKW(pB0,8),PKW(pB0,10),PKW(pB0,12),PKW(pB0,14)};pw2=(u32x4){PKW(pB1,0),PKW(pB1,2),PKW(pB1,4),PKW(pB1,6)};pw3=(u32x4){PKW(pB1,8),PKW(pB1,10),PKW(pB1,12),PKW(pB1,14)};
    SBAR(); pv(o,vb0+sl_cur,PAF(0),PAF(1),PAF(2),PAF(3)); }
  #undef PKW
  #undef PAF
  #undef VFR
  #undef PIN
  #undef MX3
  #undef GAPA
  #undef GAPB
  #undef EX
  #undef VRD
  #undef KRD
  #undef STEP
  #undef ENDW
  {auto rr=__builtin_amdgcn_permlane32_swap(__float_as_uint(l_reg),__float_as_uint(l_reg),false,false);l_reg=__uint_as_float(rr[0])+__uint_as_float(rr[1]);}
  if(hi==0)wsf[32+r32]=l_reg;asm volatile("s_waitcnt lgkmcnt(0)":::"memory");
  float rli[16];
  #pragma unroll
  for(int r=0;r<16;++r)rli[r]=__builtin_amdgcn_rcpf(wsf[32+crow(r,hi)]);
  bf16*Ow=O+(rowbase+q0+wid*QBLK)*PO;
  { bf16*stg=(bf16*)(shm+LDS_OST)+wid*2048;
    #pragma unroll
    for(int r=0;r<16;++r){const int orow=crow(r,hi);
      #pragma unroll
      for(int d0=0;d0<2;++d0)stg[orow*64+d0*32+r32]=__float2bfloat16(o[d0][r]*rli[r]);}
    asm volatile("s_waitcnt lgkmcnt(0)":::"memory");
    #pragma unroll
    for(int i=0;i<4;++i){const int row=i*8+(lane>>3),ch=lane&7; const u32x4 v=*(const u32x4*)(stg+row*64+ch*8); ATTN_STORE16(Ow+(long)row*PO+ch*8,v);} }
  asm volatile("s_waitcnt lgkmcnt(0)\n\ts_barrier":::"memory");
  #undef DMA_K
  #undef DMA_V
  #undef CMASK
  #undef START
  #undef RESC
  #undef ROT
}
constexpr int ATTN_LDS_BYTES=LDS_BYTES;
#undef SBAR
#undef WAIT_BAR
}
namespace cg = cooperative_groups;
constexpr int NWAVES = 8;
constexpr int M = 32768, DMODEL = 1024, DFF = 2816, SEQ = 2048, EV_IN = 2304, OD_IN = 1536;
constexpr float EPS = 1e-6f;
constexpr size_t MiB = 1u << 20;
constexpr size_t WS_SSQ = 432 * MiB;
constexpr size_t WS_SGUW = 2 * MiB;
constexpr size_t WS_W1T = 4 * MiB;
constexpr size_t WS_W2T = 92 * MiB;
constexpr size_t WS_EVIN = 136 * MiB;
constexpr size_t WS_EVOUT = 145 * MiB;
constexpr size_t WS_ODIN = 149 * MiB;
constexpr size_t WS_ODOUT = 155 * MiB;
constexpr size_t WS_XB = 160 * MiB;
constexpr size_t WS_PART = 224 * MiB, PART_BYTES = 26 * MiB, PART_E = PART_BYTES / 2;
constexpr size_t WS_ACT = WS_PART;
constexpr size_t WS_PROJ = WS_PART;
constexpr size_t WS_MIX = WS_PART + 18 * MiB;
constexpr size_t WS_BAR = 440 * MiB, BAR_BYTES = 32768;
constexpr size_t WS_END = 441 * MiB;
constexpr int RING_BYTES = 131072, PTAB_BYTES = 4096, MISC_OFF = RING_BYTES + PTAB_BYTES, LDS_BYTES = 147456;

#define GAS __attribute__((address_space(1)))
#define LAS __attribute__((address_space(3)))
typedef unsigned short bf16;
typedef unsigned v4u __attribute__((ext_vector_type(4)));
typedef unsigned v2u __attribute__((ext_vector_type(2)));
typedef float f32x4 __attribute__((ext_vector_type(4)));
typedef short bf16x8 __attribute__((ext_vector_type(8)));
__device__ __forceinline__ long prow(int row, int pitch) { return (long)(row >> 12) * (long)PART_E + (long)(row & 4095) * pitch; }
#define LDS_WAIT() asm volatile("s_waitcnt lgkmcnt(0)" ::: "memory")
__device__ __forceinline__ unsigned f2bf(float f) { unsigned u = __builtin_bit_cast(unsigned, f); return (u + 0x7fffu + ((u >> 16) & 1u)) >> 16; }
__device__ __forceinline__ unsigned pk2(float lo, float hi) { return pg8::cvt_pk_bf16(lo, hi); }
__device__ __forceinline__ float bflo(unsigned u) { return __builtin_bit_cast(float, u << 16); }
__device__ __forceinline__ float bfhi(unsigned u) { return __builtin_bit_cast(float, u & 0xffff0000u); }
#define UNPACK8(X_, W_) do { X_[0] = bflo(W_[0]); X_[1] = bfhi(W_[0]); X_[2] = bflo(W_[1]); X_[3] = bfhi(W_[1]); X_[4] = bflo(W_[2]); X_[5] = bfhi(W_[2]); X_[6] = bflo(W_[3]); X_[7] = bfhi(W_[3]); } while (0)
__device__ __forceinline__ float gelu_tanh(float x) {
    const float z2 = 1.5957691216057308f * (x + 0.044715f * x * x * x);
    return x * __builtin_amdgcn_rcpf(1.0f + __builtin_amdgcn_exp2f(-1.4426950408889634f * z2));
}
__device__ __forceinline__ float wave_sum(float v) {
#pragma unroll
    for (int o = 1; o < 64; o <<= 1) v += __shfl_xor(v, o);
    return v;
}

struct Args { const float* in[21]; float* out; unsigned char* ws; };
#define XB_TMO      128
#define XB_XCNT(j)  (256  + 64 * (j))
#define XB_XSUB(j)  (1280 + 64 * (j))
#define XB_XGEN(j)  (2304 + 64 * (j))
#define XB_TOP      3328
#define XB_TOPGEN   3392
#define XCD_BAR_WORDS 3456
#define XB_SPIN_CAP (1u << 18)

__device__ __forceinline__ unsigned xb_ld(unsigned* p)              { return __hip_atomic_load(p, __ATOMIC_RELAXED, __HIP_MEMORY_SCOPE_AGENT); }
__device__ __forceinline__ unsigned xb_add(unsigned* p, unsigned v) { return __hip_atomic_fetch_add(p, v, __ATOMIC_RELAXED, __HIP_MEMORY_SCOPE_AGENT); }
__device__ __forceinline__ unsigned xb_xcc_id() { return (unsigned)__builtin_amdgcn_s_getreg((3 << 11) | 20) & 0xFu; }
#define XB_SPIN(cond, bar) do { unsigned _sp = 0; while (cond) { __builtin_amdgcn_s_sleep(1); \
    if ((++_sp & 255u) == 0u) { if (xb_ld(&(bar)[XB_TMO])) break; if (_sp > XB_SPIN_CAP) { atomicAdd(&(bar)[XB_TMO], 1u); break; } } } } while (0)

struct XcdBarrier {
    unsigned* bar; unsigned x;
    volatile LAS unsigned* st;
};

__device__ __forceinline__ XcdBarrier xcd_barrier_post(unsigned* bar, volatile LAS unsigned* st) {
    XcdBarrier b; b.bar = bar; b.x = xb_xcc_id(); b.st = st;
    if (threadIdx.x == 0) (void)xb_add(&bar[XB_XCNT(b.x)], 1u);
    return b;
}
__device__ __forceinline__ void xcd_barrier_complete(unsigned* bar, unsigned x, unsigned& nloc, unsigned& nx) {
    const unsigned G = gridDim.x * gridDim.y * gridDim.z;
    unsigned sum, cnt, mine, sp = 0u;
    for (;;) {
        sum = 0u; cnt = 0u; mine = 0u;
#pragma unroll
        for (unsigned j = 0; j < 16; ++j) { const unsigned c = xb_ld(&bar[XB_XCNT(j)]); sum += c; cnt += (c > 0u) ? 1u : 0u; mine = (j == x) ? c : mine; }
        if (sum == G) break;
        __builtin_amdgcn_s_sleep(1);
        if ((++sp & 255u) == 0u) { if (xb_ld(&bar[XB_TMO])) break; if (sp > XB_SPIN_CAP) { atomicAdd(&bar[XB_TMO], 1u); break; } }
    }
    nloc = mine > 0u ? mine : 1u; nx = cnt > 0u ? cnt : 1u;
}

__device__ __forceinline__ void xcd_barrier(const XcdBarrier& b) {
    asm volatile("s_waitcnt vmcnt(0)" ::: "memory");
    __syncthreads();
    if (threadIdx.x == 0) {
        unsigned* bar = b.bar;
        __builtin_amdgcn_s_waitcnt(0);
        unsigned nloc = b.st[0], nx = b.st[1];
        if (nloc == 0u) { xcd_barrier_complete(bar, b.x, nloc, nx); b.st[0] = nloc; b.st[1] = nx; }
        const unsigned old = xb_add(&bar[XB_XSUB(b.x)], 1u);
        const unsigned gen = old / nloc;
        if (old + 1u == (gen + 1u) * nloc) {
            __builtin_amdgcn_fence(__ATOMIC_RELEASE, "agent");
            asm volatile("s_waitcnt vmcnt(0)" ::: "memory");
            const unsigned og = xb_add(&bar[XB_TOP], 1u);
            const unsigned tg = og / nx;
            if (og + 1u == (tg + 1u) * nx) xb_add(&bar[XB_TOPGEN], 1u);
            else XB_SPIN(xb_ld(&bar[XB_TOPGEN]) == tg, bar);
            __builtin_amdgcn_fence(__ATOMIC_ACQUIRE, "agent");
            xb_add(&bar[XB_XGEN(b.x)], 1u);
            asm volatile("s_waitcnt vmcnt(0)" ::: "memory");
        } else {
            XB_SPIN(xb_ld(&bar[XB_XGEN(b.x)]) == gen, bar);
            __builtin_amdgcn_fence(__ATOMIC_ACQUIRE, "agent");
            asm volatile("s_waitcnt vmcnt(0)" ::: "memory");
        }
    }
    __syncthreads();
}


enum { I_X = 0, I_F1N, I_F1WI, I_F1WO, I_MIXN, I_F2N, I_F2WI, I_F2WO, I_EVWI, I_EVCONV, I_EVQN, I_EVKN, I_EVWO, I_ODWI, I_ODPW, I_ODPS, I_ODSN, I_ODSW, I_ODSB, I_ODWO, I_FINN };

struct TrItem { const float* W; const float* gain; bf16* WT; int ldw, dstK, koff, k0, n0, drow; };
__device__ __forceinline__ TrItem tr_decode(const Args& a, int it) {
    unsigned char* ws = a.ws;
    constexpr int N_W1 = 8 * 2816, N_W2 = 8 * 1408, N_EI = 2 * 1152, N_EO = 2 * 512, N_OI = 2 * 768;
    TrItem t; t.gain = nullptr; t.koff = 0; int r = it, nblk, mode = 0;
    if (r < N_W1) { const int m = r / 2816; r -= m * 2816; const int l = m & 3, f2 = m >> 2; t.W = a.in[f2 ? I_F2WI : I_F1WI] + (size_t)l * 1024 * 5632; t.gain = a.in[f2 ? I_F2N : I_F1N] + l * 1024;
        t.WT = (bf16*)(ws + WS_W1T) + (size_t)m * 5632 * 1024; t.ldw = 5632; t.dstK = 1024; nblk = 176; mode = 1; }
    else if ((r -= N_W1) < N_W2) { const int m = r / 1408; r -= m * 1408; const int l = m & 3, f2 = m >> 2; t.W = a.in[f2 ? I_F2WO : I_F1WO] + (size_t)l * 2816 * 1024;
        t.WT = (bf16*)(ws + WS_W2T) + (size_t)m * 1024 * 2816; t.ldw = 1024; t.dstK = 2816; nblk = 32; }
    else if ((r -= N_W2) < N_EI) { const int j = r / 1152; r -= j * 1152; t.W = a.in[I_EVWI] + (size_t)j * 1024 * 2304; t.gain = a.in[I_MIXN] + (2 * j) * 1024;
        t.WT = (bf16*)(ws + WS_EVIN) + (size_t)j * 2304 * 1024; t.ldw = 2304; t.dstK = 1024; nblk = 72; }
    else if ((r -= N_EI) < N_EO) { const int j = r / 512; r -= j * 512; t.W = a.in[I_EVWO] + (size_t)j * 1024 * 1024;
        t.WT = (bf16*)(ws + WS_EVOUT) + (size_t)j * 1024 * 1024; t.ldw = 1024; t.dstK = 1024; nblk = 32; }
    else if ((r -= N_EO) < N_OI) { const int j = r / 768; r -= j * 768; t.W = a.in[I_ODWI] + (size_t)j * 1024 * 1536; t.gain = a.in[I_MIXN] + (2 * j + 1) * 1024;
        t.WT = (bf16*)(ws + WS_ODIN) + (size_t)j * 1536 * 1024; t.ldw = 1536; t.dstK = 1024; nblk = 48; }
    else { r -= N_OI; const int j = r / 256; r -= j * 256; t.W = a.in[I_ODWO] + (size_t)j * 1024 * 1024 + (size_t)512 * 1024;
        t.WT = (bf16*)(ws + WS_ODOUT) + (size_t)j * 1024 * 1024; t.ldw = 1024; t.dstK = 1024; t.koff = 512; nblk = 32; }
    const int kb = r / nblk, nb = r - kb * nblk; t.k0 = 64 * kb; t.n0 = 32 * nb; t.drow = t.n0;
    if (mode == 1) { const int nn = t.n0 < 2816 ? t.n0 : t.n0 - 2816; t.drow = (nn >> 7) * 256 + (nn & 127) + (t.n0 < 2816 ? 0 : 128); }
    return t;
}
__device__ __forceinline__ void tr_load(const TrItem& t, float (&v)[32], int lane) {
#pragma unroll
    for (int i = 0; i < 32; ++i) { const int kk = 2 * i + (lane >> 5); v[i] = t.W[(size_t)(t.k0 + kk) * t.ldw + t.n0 + (lane & 31)]; }
}
__device__ __forceinline__ void tr_store(const TrItem& t, const float (&v)[32], LAS float* scr, int lane) {
#pragma unroll
    for (int i = 0; i < 32; ++i) { const int kk = 2 * i + (lane >> 5); float w = v[i]; if (t.gain) w *= t.gain[t.k0 + kk]; scr[kk * 33 + (lane & 31)] = w; }
    LDS_WAIT(); asm volatile("" ::: "memory");
    const int c = lane & 7;
#pragma unroll
    for (int j = 0; j < 4; ++j) { const int n = (lane >> 3) + 8 * j; const LAS float* s = scr + (8 * c) * 33 + n;
        v4u o; o.x = pk2(s[0 * 33], s[1 * 33]); o.y = pk2(s[2 * 33], s[3 * 33]); o.z = pk2(s[4 * 33], s[5 * 33]); o.w = pk2(s[6 * 33], s[7 * 33]);
        *(GAS v4u*)(t.WT + (size_t)(t.drow + n) * t.dstK + t.koff + t.k0 + 8 * c) = o; }
    LDS_WAIT(); asm volatile("" ::: "memory");
}

__device__ __forceinline__ void p0_prologue(const Args& a, LAS unsigned char* lds, int gw, int NGW, int gtid, int GT, int wave, int lane) {
    unsigned char* ws = a.ws;
    LAS float* scr = (LAS float*)(lds + wave * 16384);
    constexpr int NITEMS = 8 * 2816 + 8 * 1408 + 2 * 1152 + 2 * 512 + 2 * 768 + 2 * 256;
    for (int it = gw; it < NITEMS; it += 2 * NGW) {
        const int it2 = it + NGW; const bool two = it2 < NITEMS;
        const TrItem t0 = tr_decode(a, it), t1 = tr_decode(a, two ? it2 : it);
        float v0[32], v1[32];
        tr_load(t0, v0, lane); tr_load(t1, v1, lane);
        tr_store(t0, v0, scr, lane);
        if (two) tr_store(t1, v1, scr, lane);
    }
    for (int it = gw; it < 2048; it += NGW) {
        const int j = it >> 10, g = (it >> 8) & 3, cb = (it >> 4) & 15, n = (it & 15) * 64 + lane;
        const float* pw = a.in[I_ODPW] + ((size_t)(j * 4 + g) * 128 + cb * 8) * 128; const float* sc = a.in[I_ODPS] + j * 512 + g * 128; const float* wo = a.in[I_ODWO] + (size_t)j * 1024 * 1024 + (size_t)(g * 128) * 1024 + n;
        float acc[8];
#pragma unroll
        for (int e = 0; e < 8; ++e) acc[e] = 0.f;
        for (int d0 = 0; d0 < 128; d0 += 16) { float wv[16];
#pragma unroll
            for (int d = 0; d < 16; ++d) wv[d] = wo[(size_t)(d0 + d) * 1024];
#pragma unroll
            for (int d = 0; d < 16; ++d) { const float w = wv[d] * sc[d0 + d];
#pragma unroll
                for (int e = 0; e < 8; ++e) acc[e] += pw[e * 128 + d0 + d] * w; } }
        v4u o; o.x = pk2(acc[0], acc[1]); o.y = pk2(acc[2], acc[3]); o.z = pk2(acc[4], acc[5]); o.w = pk2(acc[6], acc[7]);
        *(v4u*)((bf16*)(ws + WS_ODOUT) + (size_t)j * 1024 * 1024 + (size_t)n * 1024 + g * 128 + cb * 8) = o;
    }
    { const float* x = a.in[I_X]; bf16* xb = (bf16*)(ws + WS_XB); float* ssq0 = (float*)(ws + WS_SSQ);
      for (int m = gw; m < M; m += 2 * NGW) { const int m2 = m + NGW;
          const f32x4* xr = (const f32x4*)(x + (size_t)m * 1024) + lane; const f32x4* xr2 = (const f32x4*)(x + (size_t)(m2 < M ? m2 : m) * 1024) + lane; f32x4 v[4], v2[4]; float s = 0.f, s2 = 0.f;
#pragma unroll
          for (int j = 0; j < 4; ++j) { v[j] = xr[64 * j]; v2[j] = xr2[64 * j]; }
#pragma unroll
          for (int j = 0; j < 4; ++j) { s += (v[j].x * v[j].x + v[j].y * v[j].y) + (v[j].z * v[j].z + v[j].w * v[j].w); s2 += (v2[j].x * v2[j].x + v2[j].y * v2[j].y) + (v2[j].z * v2[j].z + v2[j].w * v2[j].w); }
          s = wave_sum(s); s2 = wave_sum(s2);
          if (lane == 0) *(f32x4*)(ssq0 + 4 * (size_t)m) = (f32x4){s, 0.f, 0.f, 0.f};
          v2u* o8 = (v2u*)(xb + (size_t)m * 1024) + lane;
#pragma unroll
          for (int j = 0; j < 4; ++j) { v2u w; w.x = pk2(v[j].x, v[j].y); w.y = pk2(v[j].z, v[j].w); o8[64 * j] = w; }
          if (m2 < M) { if (lane == 0) *(f32x4*)(ssq0 + 4 * (size_t)m2) = (f32x4){s2, 0.f, 0.f, 0.f};
              v2u* o82 = (v2u*)(xb + (size_t)m2 * 1024) + lane;
#pragma unroll
              for (int j = 0; j < 4; ++j) { v2u w; w.x = pk2(v2[j].x, v2[j].y); w.y = pk2(v2[j].z, v2[j].w); o82[64 * j] = w; } } } }
    { const f32x4* s = (const f32x4*)a.in[I_ODSW]; v2u* o = (v2u*)(ws + WS_SGUW); for (int i = gtid; i < 2 * 4 * 128 * 128 / 4; i += GT) { const f32x4 v = s[i]; v2u w; w.x = pk2(v.x, v.y); w.y = pk2(v.z, v.w); o[i] = w; } }
}

__device__ __forceinline__ void even_qk(bf16* proj, const float* qg, const float* kg, int R0, int NR, int lt, int NT) {
    for (int it = lt; it < NR * 80; it += NT) {
        const int tl = it / 80, tok = R0 + tl, r = it - tl * 80, h = r >> 3, sub = r & 7;
        bf16* p = proj + prow(tok, EV_IN) + 1536 + h * 64 + sub * 8;
        const v4u w = *(const v4u*)p; float x[8]; UNPACK8(x, w);
        float s = 0.f;
#pragma unroll
        for (int e = 0; e < 8; ++e) s += x[e] * x[e];
        s += __shfl_xor(s, 1); s += __shfl_xor(s, 2); s += __shfl_xor(s, 4);
        const float rs = __builtin_amdgcn_rsqf(s * (1.0f / 64.0f) + EPS);
        const float* gn = (h < 8 ? qg : kg) + sub * 8;
        const f32x4 g0 = *(const f32x4*)gn, g1 = *(const f32x4*)(gn + 4);
        const float gv[8] = {g0.x, g0.y, g0.z, g0.w, g1.x, g1.y, g1.z, g1.w};
        const int t = tok & (SEQ - 1); const float pos = (float)(sub < 4 ? (t >> 6) : (t & 63));
        const float osc = h < 8 ? attn_body::C2 : 1.0f;
        float o[8];
#pragma unroll
        for (int e = 0; e < 4; ++e) { const int j = (sub & 3) * 4 + e; const float inv = __builtin_amdgcn_exp2f(-(float)j * 0.83048202372184059f);
            const float ang = pos * inv, c = __cosf(ang), sn = __sinf(ang);
            const float x0 = x[2 * e] * rs * gv[2 * e], x1 = x[2 * e + 1] * rs * gv[2 * e + 1];
            o[2 * e] = (x0 * c - x1 * sn) * osc; o[2 * e + 1] = (x0 * sn + x1 * c) * osc; }
        v4u ow; ow.x = pk2(o[0], o[1]); ow.y = pk2(o[2], o[3]); ow.z = pk2(o[4], o[5]); ow.w = pk2(o[6], o[7]);
        *(v4u*)p = ow;
    }
}
__device__ __forceinline__ void even_conv(const bf16* proj, bf16* mix, const float* convw, int R0, int NR, int lt, int NT) {
    for (int it = lt; it < NR * 64; it += NT) {
        const int tok = R0 + (it >> 6), c = (it & 63) * 8, t = tok & (SEQ - 1);
        const bf16* pr = proj + prow(tok, EV_IN) + c;
        const v4u zero = (v4u){0u, 0u, 0u, 0u};
        const v4u wb = *(const v4u*)pr, wc1 = *(const v4u*)(pr + 512), wh1 = *(const v4u*)(pr + 1024);
        const v4u wc0 = t > 0 ? *(const v4u*)(pr - EV_IN + 512) : zero, wh0 = t > 0 ? *(const v4u*)(pr - EV_IN + 1024) : zero;
        const v4u wc2 = t < SEQ - 1 ? *(const v4u*)(pr + EV_IN + 512) : zero, wh2 = t < SEQ - 1 ? *(const v4u*)(pr + EV_IN + 1024) : zero;
        float gb[8], c0[8], h0[8], c1[8], h1[8], c2[8], h2[8];
        UNPACK8(gb, wb); UNPACK8(c0, wc0); UNPACK8(h0, wh0); UNPACK8(c1, wc1); UNPACK8(h1, wh1); UNPACK8(c2, wc2); UNPACK8(h2, wh2);
        const f32x4 a0 = *(const f32x4*)(convw + c), a1 = *(const f32x4*)(convw + c + 4), b0 = *(const f32x4*)(convw + 512 + c), b1 = *(const f32x4*)(convw + 512 + c + 4), d0 = *(const f32x4*)(convw + 1024 + c), d1 = *(const f32x4*)(convw + 1024 + c + 4);
        const float w0[8] = {a0.x, a0.y, a0.z, a0.w, a1.x, a1.y, a1.z, a1.w}, w1[8] = {b0.x, b0.y, b0.z, b0.w, b1.x, b1.y, b1.z, b1.w}, w2[8] = {d0.x, d0.y, d0.z, d0.w, d1.x, d1.y, d1.z, d1.w};
        float o[8];
#pragma unroll
        for (int e = 0; e < 8; ++e) o[e] = gb[e] * (w0[e] * (c0[e] * h0[e]) + w1[e] * (c1[e] * h1[e]) + w2[e] * (c2[e] * h2[e]));
        v4u ow; ow.x = pk2(o[0], o[1]); ow.y = pk2(o[2], o[3]); ow.z = pk2(o[4], o[5]); ow.w = pk2(o[6], o[7]);
        *(v4u*)(mix + prow(tok, 1024) + c) = ow;
    }
}

template <int R> __device__ __forceinline__ void pool_item(const bf16* pb, bf16* mp, int t) {
    v4u w[2 * R + 1];
#pragma unroll
    for (int d = 0; d <= 2 * R; ++d) { const int tt = t + d - R; w[d] = (tt >= 0 && tt < SEQ) ? *(const v4u*)(pb + (size_t)tt * OD_IN) : (v4u){0u, 0u, 0u, 0u}; }
    float acc[8];
#pragma unroll
    for (int e = 0; e < 8; ++e) acc[e] = 0.f;
#pragma unroll
    for (int d = 0; d <= 2 * R; ++d) { float x[8]; UNPACK8(x, w[d]);
#pragma unroll
        for (int e = 0; e < 8; ++e) acc[e] += x[e]; }
    const int lo = t - R < 0 ? 0 : t - R, hi = t + R > SEQ - 1 ? SEQ - 1 : t + R;
    const float inv = 1.0f / (float)(hi - lo + 1);
    float xs[8]; UNPACK8(xs, w[R]);
    v4u ow; ow.x = pk2(acc[0] * inv - xs[0], acc[1] * inv - xs[1]); ow.y = pk2(acc[2] * inv - xs[2], acc[3] * inv - xs[3]);
    ow.z = pk2(acc[4] * inv - xs[4], acc[5] * inv - xs[5]); ow.w = pk2(acc[6] * inv - xs[6], acc[7] * inv - xs[7]);
    *(v4u*)mp = ow;
}
__device__ __forceinline__ void odd_pool(const bf16* proj, bf16* mix, int R0, int NR, int w, int NW, int lane) {
    for (int wi = w; wi < NR; wi += NW) {
        const int g = wi & 3, tok = R0 + (wi >> 2) * 4 + (lane >> 4), c = g * 128 + (lane & 15) * 8, t = tok & (SEQ - 1);
        const bf16* pb = proj + prow(tok - t, OD_IN) + c; bf16* mp = mix + prow(tok, 1024) + c;
        if (g == 0) pool_item<1>(pb, mp, t); else if (g == 1) pool_item<2>(pb, mp, t); else if (g == 2) pool_item<4>(pb, mp, t); else pool_item<8>(pb, mp, t);
    }
}

__device__ __forceinline__ void sgu_chunk(int ch, const bf16* proj, const bf16* sguw, const float* norm_g, const float* b_s, bf16* mix, LAS unsigned char* lds, int tid, int lane, int wave) {
    LAS float* rstd = (LAS float*)lds;
    LAS unsigned short* vnT = (LAS unsigned short*)(lds + 512);
    const size_t row0 = 0; proj += prow(ch * 128, OD_IN); mix += prow(ch * 128, 1024);
    const int q = tid >> 2, part = tid & 3, fr = lane & 15, fq = lane >> 4;
    { const bf16* vp = proj + (row0 + q) * OD_IN + 1024 + part * 128; float s = 0.f;
#pragma unroll 4
      for (int i = 0; i < 16; ++i) { const v4u w = *(const v4u*)(vp + 8 * i); float x[8]; UNPACK8(x, w);
#pragma unroll
          for (int e = 0; e < 8; ++e) { const float gl = gelu_tanh(x[e]); s += gl * gl; } }
      s += __shfl_xor(s, 1); s += __shfl_xor(s, 2);
      if (part == 0) rstd[q] = __builtin_amdgcn_rsqf(s * (1.0f / 512.0f) + EPS); }
    __syncthreads();
    for (int g = 0; g < 4; ++g) {
        { const float rs = rstd[q]; const int cs = part * 32; const bf16* vp = proj + (row0 + q) * OD_IN + 1024 + g * 128 + cs; const float* ng = norm_g + g * 128 + cs;
#pragma unroll
          for (int i = 0; i < 4; ++i) { const v4u w = *(const v4u*)(vp + 8 * i); float x[8]; UNPACK8(x, w);
              const f32x4 n0 = *(const f32x4*)(ng + 8 * i), n1 = *(const f32x4*)(ng + 8 * i + 4); const float nv[8] = {n0.x, n0.y, n0.z, n0.w, n1.x, n1.y, n1.z, n1.w};
#pragma unroll
              for (int e = 0; e < 8; ++e) vnT[(cs + 8 * i + e) * 136 + q] = (unsigned short)f2bf(gelu_tanh(x[e]) * rs * nv[e]); } }
        __syncthreads();
        f32x4 acc[8];
#pragma unroll
        for (int n = 0; n < 8; ++n) acc[n] = (f32x4){0.f, 0.f, 0.f, 0.f};
        const int p = 16 * wave + fr;
#pragma unroll
        for (int ks = 0; ks < 4; ++ks) { const bf16x8 af = *(const bf16x8*)(sguw + ((size_t)(g * 128 + p) * 128 + 32 * ks + 8 * fq));
#pragma unroll
            for (int n = 0; n < 8; ++n) { const bf16x8 bfv = *(const LAS bf16x8*)(vnT + (16 * n + fr) * 136 + 32 * ks + 8 * fq);
                acc[n] = __builtin_amdgcn_mfma_f32_16x16x32_bf16(bfv, af, acc[n], 0, 0, 0); } }
        const float bias = b_s[g * 128 + p];
        const bf16* up = proj + (row0 + p) * OD_IN + 512 + g * 128 + 4 * fq; bf16* op = mix + (row0 + p) * 1024 + 512 + g * 128 + 4 * fq;
#pragma unroll
        for (int n = 0; n < 8; ++n) { const v2u uw = *(const v2u*)(up + 16 * n);
            v2u ow; ow.x = pk2(gelu_tanh(bflo(uw.x)) * (acc[n][0] + bias), gelu_tanh(bfhi(uw.x)) * (acc[n][1] + bias)); ow.y = pk2(gelu_tanh(bflo(uw.y)) * (acc[n][2] + bias), gelu_tanh(bfhi(uw.y)) * (acc[n][3] + bias));
            *(v2u*)(op + 16 * n) = ow; }
        __syncthreads();
    }
}

#define LB_SUB(j) (3456 + 64 * (j))
#define LB_GEN(j) (4480 + 64 * (j))
struct Ctx { int tid, lane, wave, G, vb, bi, nb, R0, NR, w, NW, lt, NT; };
__device__ __forceinline__ Ctx mkctx(LAS unsigned char* lds) {
    Ctx c; int t = threadIdx.x; asm volatile("" : "+v"(t)); int g = gridDim.x, b = blockIdx.x; asm volatile("" : "+s"(g), "+s"(b));
    volatile LAS unsigned* MISC = (volatile LAS unsigned*)(lds + MISC_OFF);
    const int loc = __builtin_amdgcn_readfirstlane((int)MISC[4]), xv = __builtin_amdgcn_readfirstlane((int)MISC[6]), rank = __builtin_amdgcn_readfirstlane((int)MISC[7]);
    c.tid = t; c.lane = t & 63; c.wave = __builtin_amdgcn_readfirstlane(t >> 6); c.G = g;
    const int vcu = (g % 8 == 0) ? (b % 8) * (g / 8) + b / 8 : b;
    c.vb = loc ? rank * 8 + xv : b;
    c.bi = loc ? rank : vcu; c.nb = loc ? 32 : g; c.R0 = loc ? 4096 * xv : 0; c.NR = loc ? 4096 : M;
    c.w = c.bi * NWAVES + c.wave; c.NW = c.nb * NWAVES; c.lt = c.bi * (NWAVES * 64) + t; c.NT = c.nb * NWAVES * 64; return c;
}
__device__ __forceinline__ const Args* kargs() { auto p = __builtin_amdgcn_kernarg_segment_ptr(); asm volatile("" : "+s"(p)); return (const Args*)p; }
#define CG_SYNC() do { asm volatile("s_waitcnt vmcnt(0) lgkmcnt(0)" ::: "memory"); __syncthreads(); cg::this_grid().sync(); __builtin_amdgcn_fence(__ATOMIC_ACQUIRE, "agent"); asm volatile("s_waitcnt vmcnt(0)" ::: "memory"); } while (0)
__device__ __forceinline__ void seam(LAS unsigned char* lds) {
    volatile LAS unsigned* MISC = (volatile LAS unsigned*)(lds + MISC_OFF);
    unsigned* bar = (unsigned*)(kargs()->ws + WS_BAR);
    if (__builtin_amdgcn_readfirstlane((int)MISC[4])) {
        asm volatile("s_waitcnt vmcnt(0)" ::: "memory");
        __syncthreads();
        if (threadIdx.x == 0) {
            __builtin_amdgcn_s_waitcnt(0);
            const unsigned x = MISC[5];
            const unsigned old = xb_add(&bar[LB_SUB(x)], 1u), gen = old >> 5;
            if ((old & 31u) == 31u) xb_add(&bar[LB_GEN(x)], 1u);
            else XB_SPIN(xb_ld(&bar[LB_GEN(x)]) == gen, bar);
            __builtin_amdgcn_fence(__ATOMIC_ACQUIRE, "agent");
            asm volatile("s_waitcnt vmcnt(0)" ::: "memory");
        }
        __syncthreads();
    } else { XcdBarrier b_; b_.bar = bar; b_.x = xb_xcc_id(); b_.st = MISC; xcd_barrier(b_); }
}
#define GRID_SYNC() seam(lds)

__global__ void __launch_bounds__(NWAVES * 64, 2) mega_fwd(Args args_unused) {
    extern __shared__ __attribute__((aligned(16))) unsigned char lds_raw[];
    LAS unsigned char* lds = (LAS unsigned char*)lds_raw;
    if (threadIdx.x == 0) {
        volatile LAS unsigned* MISC = (volatile LAS unsigned*)(lds + MISC_OFF); unsigned* bar = (unsigned*)(kargs()->ws + WS_BAR);
        const unsigned x = xb_xcc_id(); const unsigned rank = xb_add(&bar[XB_XCNT(x)], 1u);
        MISC[0] = 0u; MISC[1] = 0u; MISC[4] = 0u; MISC[5] = x; MISC[6] = 0u; MISC[7] = rank;
    }
    __syncthreads();
    for (int rp = 0; rp <= 0; ++rp) { const Ctx c = mkctx(lds); const Args* A = kargs(); p0_prologue(*A, lds, c.w, c.NW, c.lt, c.NT, c.wave, c.lane); }
    CG_SYNC();
    if (threadIdx.x == 0) {
        volatile LAS unsigned* MISC = (volatile LAS unsigned*)(lds + MISC_OFF); unsigned* bar = (unsigned*)(kargs()->ws + WS_BAR);
        const unsigned x = MISC[5]; unsigned npop = 0u, below = 0u; bool ok = gridDim.x == 256u;
        for (unsigned j = 0; j < 16; ++j) { const unsigned cnt = xb_ld(&bar[XB_XCNT(j)]); if (cnt) { ++npop; ok = ok && cnt == 32u; if (j < x) ++below; } }
        ok = ok && npop == 8u && MISC[7] < 32u;
        MISC[6] = below; MISC[4] = ok ? 1u : 0u;
    }
    __syncthreads();

    for (int j = 0; j < 12; ++j) {
        const int l = j / 3, kind = j - 3 * l;
        if (kind != 1) {
            const int wi = (kind == 2 ? 4 : 0) + l;
            { const Ctx c = mkctx(lds); const Args* A = kargs(); unsigned char* ws = A->ws;
              pg8::Gemm g{(const bf16*)(ws + WS_XB), (const bf16*)(ws + WS_W1T) + (size_t)wi * 5632 * 1024, M, 2 * DFF, DMODEL, 0}; pg8::StaticOrder S; S.init(M, 2 * DFF, c.G, c.vb);
              pg8::EpiSwiGLU E{(bf16*)(ws + WS_ACT), DFF, (const float*)(ws + WS_SSQ) + (size_t)j * M * 4, (long)PART_E - 4096L * DFF};
              pg8::gemm_phase<pg8::EpiSwiGLU, pg8::StaticOrder, true, true>(lds, g, S, E); }
            GRID_SYNC();
        } else {
            const int jj = l >> 1; const bool even = (l & 1) == 0;
            { const Ctx c = mkctx(lds); const Args* A = kargs(); unsigned char* ws = A->ws; const int N = even ? EV_IN : OD_IN;
              const bf16* wt = even ? (const bf16*)(ws + WS_EVIN) + (size_t)jj * EV_IN * 1024 : (const bf16*)(ws + WS_ODIN) + (size_t)jj * OD_IN * 1024;
              pg8::Gemm g{(const bf16*)(ws + WS_XB), wt, M, N, DMODEL, 0}; pg8::StaticOrder S; S.init(M, N, c.G, c.vb);
              pg8::EpiRowScale E{(bf16*)(ws + WS_PROJ), N, (const float*)(ws + WS_SSQ) + (size_t)j * M * 4, (long)PART_E - 4096L * N};
              pg8::gemm_phase<pg8::EpiRowScale, pg8::StaticOrder, true, true>(lds, g, S, E); }
            GRID_SYNC();
            if (even) {
                { const Ctx c = mkctx(lds); const Args* A = kargs(); unsigned char* ws = A->ws;
                  even_qk((bf16*)(ws + WS_PROJ), A->in[I_EVQN] + jj * 64, A->in[I_EVKN] + jj * 64, c.R0, c.NR, c.lt, c.NT);
                  even_conv((const bf16*)(ws + WS_PROJ), (bf16*)(ws + WS_MIX), A->in[I_EVCONV] + jj * 3 * 512, c.R0, c.NR, c.lt, c.NT); }
                GRID_SYNC();
                { const Ctx c = mkctx(lds); const Args* A = kargs(); unsigned char* ws = A->ws; const attn_body::bf16* PROJ = (const attn_body::bf16*)(ws + WS_PROJ); attn_body::bf16* MIX = (attn_body::bf16*)(ws + WS_MIX);
                  const int NU = (c.NR >> 11) * 64, b0 = c.R0 >> 11;
                  for (int ui = c.bi; ui < NU; ui += c.nb) {
                      const int b = b0 + (ui >> 6), h = (ui >> 3) & 7, qb = ui & 7, kvh = h >> 2;
                      const attn_body::bf16* Pp = PROJ + (long)(b >> 1) * (long)PART_E; attn_body::bf16* Mp = MIX + (long)(b >> 1) * (long)PART_E;
                      attn_body::attn_unit<8>(b & 1, qb, Pp + 1536 + h * 64, Pp + 2048 + kvh * 64, Pp + 2176 + kvh * 64, Mp + 512 + h * 64, (char*)lds_raw);
                  } }
            } else {
                { const Ctx c = mkctx(lds); const Args* A = kargs(); unsigned char* ws = A->ws; odd_pool((const bf16*)(ws + WS_PROJ), (bf16*)(ws + WS_MIX), c.R0, c.NR, c.w, c.NW, c.lane); }
                { const Ctx c = mkctx(lds); const Args* A = kargs(); unsigned char* ws = A->ws;
                  for (int ch = (c.R0 >> 7) + c.bi; ch < ((c.R0 + c.NR) >> 7); ch += c.nb)
                      sgu_chunk(ch, (const bf16*)(ws + WS_PROJ), (const bf16*)(ws + WS_SGUW) + (size_t)jj * 4 * 128 * 128, A->in[I_ODSN] + jj * 512, A->in[I_ODSB] + jj * 512, (bf16*)(ws + WS_MIX), lds, c.tid, c.lane, c.wave); }
            }
            GRID_SYNC();
        }
        { const Ctx c = mkctx(lds); const Args* A = kargs(); unsigned char* ws = A->ws; const bool ffn = kind != 1; const int jj = l >> 1;
          const bf16* wt = ffn ? (const bf16*)(ws + WS_W2T) + (size_t)((kind == 2 ? 4 : 0) + l) * 1024 * 2816 : ((l & 1) == 0 ? (const bf16*)(ws + WS_EVOUT) : (const bf16*)(ws + WS_ODOUT)) + (size_t)jj * 1024 * 1024;
          pg8::Gemm g{ffn ? (const bf16*)(ws + WS_ACT) : (const bf16*)(ws + WS_MIX), wt, M, DMODEL, ffn ? DFF : DMODEL, 2 * ((long)PART_E - 4096L * (ffn ? DFF : DMODEL))}; pg8::StaticOrder S; S.init(M, DMODEL, c.G, c.vb);
          pg8::EpiResid E{(bf16*)(ws + WS_XB), (float*)(ws + WS_SSQ) + (size_t)(j + 1) * M * 4, ffn ? 0.5f : 1.0f};
          pg8::gemm_phase<pg8::EpiResid, pg8::StaticOrder, true, true>(lds, g, S, E); }
        GRID_SYNC();
    }
    { const Ctx c = mkctx(lds); const Args* A = kargs(); float* out = A->out; const bf16* xb = (const bf16*)(A->ws + WS_XB); const float* ssq = (const float*)(A->ws + WS_SSQ) + (size_t)12 * M * 4; const f32x4* gf = (const f32x4*)A->in[I_FINN];
      for (int mi = c.w; mi < c.NR; mi += c.NW) { const int m = c.R0 + mi; const float rs = pg8::row_rs(ssq, m); const v2u* xr = (const v2u*)(xb + (size_t)m * 1024) + c.lane; f32x4* orow = (f32x4*)(out + (size_t)m * 1024) + c.lane;
#pragma unroll
          for (int q = 0; q < 4; ++q) { const v2u w = xr[64 * q]; const f32x4 v = {bflo(w.x), bfhi(w.x), bflo(w.y), bfhi(w.y)}; orow[64 * q] = v * rs * gf[c.lane + 64 * q]; } } }
}

extern "C" void kernel_launch(void* const* d_in, const int* in_sizes, int n_in, void* d_out, int out_size, void* d_ws, size_t ws_size, hipStream_t stream) {
    static int grid = 0;
    if (grid == 0) {
        if (n_in != 21 || in_sizes[0] != M * DMODEL || out_size != M * DMODEL || ws_size < WS_END) { fprintf(stderr, "kernel_launch: unexpected shapes (n_in %d, in0 %d, out %d, ws %zu)\n", n_in, n_in > 0 ? in_sizes[0] : -1, out_size, ws_size); grid = -1; return; }
        int dev = 0, cus = 0, per_cu = 0;
        if (hipGetDevice(&dev) != hipSuccess || hipDeviceGetAttribute(&cus, hipDeviceAttributeMultiprocessorCount, dev) != hipSuccess) { grid = -1; return; }
        if (hipFuncSetAttribute((const void*)mega_fwd, hipFuncAttributeMaxDynamicSharedMemorySize, LDS_BYTES) != hipSuccess) { fprintf(stderr, "kernel_launch: hipFuncSetAttribute failed\n"); grid = -1; return; }
        if (hipOccupancyMaxActiveBlocksPerMultiprocessor(&per_cu, (const void*)mega_fwd, NWAVES * 64, LDS_BYTES) != hipSuccess || per_cu < 1) { fprintf(stderr, "kernel_launch: occupancy query says %d\n", per_cu); per_cu = 1; }
        (void)hipGetLastError();
        grid = cus * per_cu;
    }
    if (grid < 0) return;
    if (hipMemsetAsync((char*)d_ws + WS_BAR, 0, BAR_BYTES, stream) != hipSuccess) { fprintf(stderr, "kernel_launch: hipMemsetAsync failed\n"); return; }
    Args a{};
    for (int i = 0; i < 21; ++i) a.in[i] = (const float*)d_in[i];
    a.out = (float*)d_out; a.ws = (unsigned char*)d_ws;
    void* params[] = {&a};
    hipError_t e = hipLaunchCooperativeKernel((const void*)mega_fwd, dim3(grid), dim3(NWAVES * 64), params, LDS_BYTES, stream);
    if (e != hipSuccess) fprintf(stderr, "kernel_launch: cooperative launch failed: %s (grid %d)\n", hipGetErrorString(e), grid);
}
```
